# Optimizing an MI355X kernel written in HIP

```python
import math
import jax, jax.numpy as jnp
from jax import lax
import numpy as np

D_MODEL = 1024
BATCH = 2
SEQ = 8192
DEPTH = 2
DEC_BATCH = 32
DEC_SEQ = 4
PAST_LEN = 8192
PAGE_SIZE = 128

HEAD_DIM = 64
N_HEADS = 12
MIX_W = N_HEADS * HEAD_DIM
N_MEM_HEADS = 4
MEM_W = N_MEM_HEADS * HEAD_DIM
N_MEM = 256
N_KV_B = 4
KV_GROUP = N_HEADS // N_KV_B
CONV_W = 4
DN_CONV_CH = 3 * MIX_W
DN_CHUNK = 64
MOBA_BLOCK = 256
MOBA_TOPK = 3
MOBA_Q_CHUNK = 32
ROT_DIM = HEAD_DIM // 4
ROPE_THETA = 500000.0
D_FF = 2816
N_A = DEPTH // 2
N_B = DEPTH - N_A
IN_A = 4 * MIX_W + 2 * N_HEADS + MEM_W
IN_B = MIX_W + MEM_W
OUT_W = MIX_W + MEM_W
EPS = 1e-6
F32 = jnp.float32

kernel_name = 'yoco_gdn_moba_macaron_memory_step'


def rmsnorm(x, g):
    xf = x.astype(F32)
    y = xf * lax.rsqrt(jnp.mean(xf * xf, axis=-1, keepdims=True) + EPS)
    return (y * g.astype(F32)).astype(x.dtype)


def l2norm(t):
    tf = t.astype(F32)
    return tf * lax.rsqrt(jnp.sum(tf * tf, axis=-1, keepdims=True) + EPS)


def swiglu(x, g, w1, w3, w2):
    h = rmsnorm(x, g)
    return (jax.nn.silu(h @ w1) * (h @ w3)) @ w2


def partial_rope(x, pos):
    half = ROT_DIM // 2
    inv = ROPE_THETA ** (-jnp.arange(half, dtype=F32) * 2.0 / ROT_DIM)
    ang = pos.astype(F32)[:, None] * inv[None, :]
    cos = jnp.cos(ang)[:, None, :]
    sin = jnp.sin(ang)[:, None, :]
    xf = x.astype(F32)
    x1 = xf[..., :half]
    x2 = xf[..., half:ROT_DIM]
    out = jnp.concatenate([x1 * cos - x2 * sin, x2 * cos + x1 * sin, xf[..., ROT_DIM:]], axis=-1)
    return out.astype(x.dtype)


def short_conv(u, buf, w):
    L = u.shape[1]
    up = jnp.concatenate([buf.astype(u.dtype), u], axis=1)
    y = sum(up[:, j:j + L] * w[j] for j in range(CONV_W))
    return jax.nn.silu(y), up[:, up.shape[1] - (CONV_W - 1):]


def gated_delta_rule(q, k, v, g, beta, s0):
    B, L, H, d = q.shape
    C = math.gcd(L, DN_CHUNK)
    N = L // C

    def ch4(t):
        return t.reshape(B, N, C, H, d).transpose(0, 3, 1, 2, 4)

    def ch3(t):
        return t.reshape(B, N, C, H).transpose(0, 3, 1, 2)

    qc = ch4(q.astype(F32)) * (d ** -0.5)
    kc = ch4(k.astype(F32))
    vc = ch4(v.astype(F32))
    gc = lax.cumsum(ch3(g.astype(F32)), axis=3)
    bc = ch3(beta.astype(F32))
    kb = kc * bc[..., None]
    vb = vc * bc[..., None]
    tril = jnp.tril(jnp.ones((C, C), dtype=bool))
    strict = jnp.tril(jnp.ones((C, C), dtype=bool), -1)
    diff = gc[..., :, None] - gc[..., None, :]
    decay = jnp.exp(jnp.where(tril, diff, -jnp.inf))
    m = jnp.einsum('bhncd,bhnsd->bhncs', kb, kc) * jnp.where(strict, decay, 0.0)
    tmat = jnp.eye(C, dtype=F32) + m
    rhs = jnp.concatenate([vb, kb * jnp.exp(gc)[..., None]], axis=-1)
    sol = lax.linalg.triangular_solve(tmat, rhs, left_side=True, lower=True, unit_diagonal=True)
    u = sol[..., :d]
    w = sol[..., d:]
    a_intra = jnp.einsum('bhncd,bhnsd->bhncs', qc, kc) * decay

    def step(S, xs):
        qi, ki, ui, wi, gi, ai = xs
        v_new = ui - jnp.einsum('bhcd,bhde->bhce', wi, S)
        o = (jnp.einsum('bhcd,bhde->bhce', qi * jnp.exp(gi)[..., None], S)
             + jnp.einsum('bhcs,bhse->bhce', ai, v_new))
        glast = gi[..., -1]
        S = (S * jnp.exp(glast)[..., None, None]
             + jnp.einsum('bhcd,bhce->bhde', ki * jnp.exp(glast[..., None] - gi)[..., None], v_new))
        return S, o

    xs = tuple(jnp.moveaxis(t, 2, 0) for t in (qc, kc, u, w, gc, a_intra))
    s_fin, o = lax.scan(step, s0.astype(F32), xs)
    o = o.transpose(1, 0, 3, 2, 4).reshape(B, L, H, d)
    return o, s_fin


def mem_kv(mem, g, w):
    B = mem.shape[0]
    k, v = jnp.split(rmsnorm(mem, g) @ w, 2, axis=-1)
    return (k.reshape(B, N_MEM, N_MEM_HEADS, HEAD_DIM), v.reshape(B, N_MEM, N_MEM_HEADS, HEAD_DIM))


def mem_attend(q, mk, mv):
    s = jnp.einsum('blhd,bmhd->bhlm', q, mk.astype(q.dtype)).astype(F32) * (HEAD_DIM ** -0.5)
    p = jax.nn.softmax(s, axis=-1).astype(q.dtype)
    return jnp.einsum('bhlm,bmhd->blhd', p, mv.astype(q.dtype))


def moba_attend(q, q_pos, K, V):
    B, Lq = q.shape[0], q.shape[1]
    T = K.shape[1]
    NB = -(-T // MOBA_BLOCK)
    pad = NB * MOBA_BLOCK - T
    Kb = jnp.pad(K, ((0, 0), (0, pad), (0, 0), (0, 0))).reshape(B, NB, MOBA_BLOCK, N_KV_B, HEAD_DIM)
    Vb = jnp.pad(V, ((0, 0), (0, pad), (0, 0), (0, 0))).reshape(B, NB, MOBA_BLOCK, N_KV_B, HEAD_DIM)
    head_kv = jnp.arange(N_HEADS) // KV_GROUP
    kbar = jnp.mean(Kb.astype(F32), axis=2)[:, :, head_kv]
    gate = jnp.einsum('blhd,bnhd->blhn', q.astype(F32), kbar)
    qblk = q_pos // MOBA_BLOCK
    past = jnp.arange(NB)[None, :] < qblk[:, None]
    gate = jnp.where(past[None, :, None, :], gate, -jnp.inf)
    k_sel = min(MOBA_TOPK, NB)
    _, top_idx = lax.top_k(gate, k_sel)
    sel_valid = top_idx < qblk[None, :, None, None]
    own = jnp.broadcast_to(qblk[None, :, None, None], (B, Lq, N_HEADS, 1)).astype(top_idx.dtype)
    idx = jnp.concatenate([top_idx, own], axis=-1)
    valid = jnp.concatenate([sel_valid, jnp.ones((B, Lq, N_HEADS, 1), dtype=bool)], axis=-1)
    n_slots = k_sel + 1
    Kt = jnp.moveaxis(Kb, 3, 1)
    Vt = jnp.moveaxis(Vb, 3, 1)
    bi = jnp.arange(B)[:, None, None, None]
    hk = head_kv[None, None, :, None]
    qc = math.gcd(Lq, MOBA_Q_CHUNK)
    nq = Lq // qc

    def attend(args):
        q_c, pos_c, idx_c, valid_c = args
        kg = Kt[bi, hk, idx_c].astype(q_c.dtype)
        vg = Vt[bi, hk, idx_c].astype(q_c.dtype)
        s = jnp.einsum('bqhd,bqhsjd->bqhsj', q_c, kg).astype(F32) * (HEAD_DIM ** -0.5)
        kpos = idx_c[..., None] * MOBA_BLOCK + jnp.arange(MOBA_BLOCK)
        mask = valid_c[..., None] & (kpos <= pos_c[None, :, None, None, None])
        s = jnp.where(mask, s, -jnp.inf).reshape(B, qc, N_HEADS, n_slots * MOBA_BLOCK)
        p = jax.nn.softmax(s, axis=-1).reshape(B, qc, N_HEADS, n_slots, MOBA_BLOCK).astype(q_c.dtype)
        return jnp.einsum('bqhsj,bqhsjd->bqhd', p, vg)

    def to_chunks(t):
        return jnp.moveaxis(t.reshape(B, nq, qc, *t.shape[2:]), 1, 0)

    out = lax.map(attend, (to_chunks(q), q_pos.reshape(nq, qc), to_chunks(idx), to_chunks(valid)))
    return jnp.moveaxis(out, 0, 1).reshape(B, Lq, N_HEADS, HEAD_DIM)


def deltanet_branch(p, a, h, conv_buf, s0):
    B, L, _ = h.shape
    proj = h @ p['w_in_a'][a]
    qkv, gate, a_in, b_in, q_mem = jnp.split(
        proj, [3 * MIX_W, 4 * MIX_W, 4 * MIX_W + N_HEADS, 4 * MIX_W + 2 * N_HEADS], axis=-1)
    qkv, new_buf = short_conv(qkv, conv_buf, p['dn_conv_w'][a])
    q, k, v = [t.reshape(B, L, N_HEADS, HEAD_DIM) for t in jnp.split(qkv, 3, axis=-1)]
    g = -jnp.exp(p['dn_a_log'][a].astype(F32)) * jax.nn.softplus(a_in.astype(F32) + p['dn_dt_bias'][a].astype(F32))
    beta = jax.nn.sigmoid(b_in.astype(F32))
    o, s_fin = gated_delta_rule(l2norm(q), l2norm(k), v, g, beta, s0)
    o = rmsnorm(o.astype(h.dtype), p['dn_out_norm'][a]) * jax.nn.silu(gate.reshape(B, L, N_HEADS, HEAD_DIM))
    return o, q_mem, new_buf, s_fin.astype(s0.dtype)


def run_trunk(p, x, pos, mem_k, mem_v, conv0, s0, past_k, past_v):
    B, L, _ = x.shape
    new_conv, new_s = [], []
    K = V = k_new = v_new = None
    for l in range(DEPTH):
        if l == N_A:
            k_new, v_new = jnp.split(rmsnorm(x, p['kv_norm']) @ p['w_kv'], 2, axis=-1)
            k_new = partial_rope(k_new.reshape(B, L, N_KV_B, HEAD_DIM), pos)
            v_new = v_new.reshape(B, L, N_KV_B, HEAD_DIM)
            if past_k is None:
                K, V = k_new, v_new
            else:
                K = jnp.concatenate([past_k.astype(k_new.dtype), k_new], axis=1)
                V = jnp.concatenate([past_v.astype(v_new.dtype), v_new], axis=1)
        x = x + 0.5 * swiglu(x, p['ffn1_norm'][l], p['ffn1_w1'][l], p['ffn1_w3'][l], p['ffn1_w2'][l])
        h = rmsnorm(x, p['mix_norm'][l])
        if l < N_A:
            o, q_mem, cbuf, s_fin = deltanet_branch(p, l, h, conv0[l], s0[l])
            new_conv.append(cbuf)
            new_s.append(s_fin)
        else:
            q, q_mem = jnp.split(h @ p['w_in_b'][l - N_A], [MIX_W], axis=-1)
            q = partial_rope(q.reshape(B, L, N_HEADS, HEAD_DIM), pos)
            o = moba_attend(q, pos, K, V)
        mo = mem_attend(q_mem.reshape(B, L, N_MEM_HEADS, HEAD_DIM), mem_k[l], mem_v[l])
        mix = jnp.concatenate([o.reshape(B, L, MIX_W).astype(x.dtype), mo.reshape(B, L, MEM_W).astype(x.dtype)], axis=-1)
        x = x + mix @ p['w_out'][l]
        x = x + 0.5 * swiglu(x, p['ffn2_norm'][l], p['ffn2_w1'][l], p['ffn2_w3'][l], p['ffn2_w2'][l])
    return rmsnorm(x, p['final_norm']), jnp.stack(new_conv), jnp.stack(new_s), k_new, v_new


def setup_inputs(seed: int = 0) -> dict:
    key = jax.random.key(seed)
    cnt = [0]

    def sub():
        cnt[0] += 1
        return jax.random.fold_in(key, cnt[0])

    def nrm(shape, scale):
        return jax.random.normal(sub(), shape, F32) * scale

    def gain(shape):
        return 1.0 + nrm(shape, 0.02)

    n_pages = PAST_LEN // PAGE_SIZE
    n_pool = (DEC_BATCH * n_pages * 5) // 4
    page_table = jax.random.permutation(sub(), n_pool)[:DEC_BATCH * n_pages].reshape(DEC_BATCH, n_pages).astype(jnp.int32)
    dt = jnp.exp(jax.random.uniform(sub(), (N_A, N_HEADS), F32, math.log(1e-3), math.log(1e-1)))
    return {
        'x_prompt': nrm((BATCH, SEQ, D_MODEL), 1.0),
        'x_sample': nrm((DEC_BATCH, DEC_SEQ, D_MODEL), 1.0),
        'mem_prompt': nrm((BATCH, N_MEM, D_MODEL), 1.0),
        'cache_mem_k': nrm((DEPTH, DEC_BATCH, N_MEM, N_MEM_HEADS, HEAD_DIM), 1.0),
        'cache_mem_v': nrm((DEPTH, DEC_BATCH, N_MEM, N_MEM_HEADS, HEAD_DIM), 1.0),
        'state_dn_conv': nrm((N_A, DEC_BATCH, CONV_W - 1, DN_CONV_CH), 1.0),
        'state_dn_S': nrm((N_A, DEC_BATCH, N_HEADS, HEAD_DIM, HEAD_DIM), 0.1),
        'cache_kv_k': nrm((n_pool, PAGE_SIZE, N_KV_B, HEAD_DIM), 1.0),
        'cache_kv_v': nrm((n_pool, PAGE_SIZE, N_KV_B, HEAD_DIM), 1.0),
        'page_table': page_table,
        'ffn1_norm': gain((DEPTH, D_MODEL)),
        'ffn1_w1': nrm((DEPTH, D_MODEL, D_FF), D_MODEL ** -0.5),
        'ffn1_w3': nrm((DEPTH, D_MODEL, D_FF), D_MODEL ** -0.5),
        'ffn1_w2': nrm((DEPTH, D_FF, D_MODEL), D_FF ** -0.5),
        'mix_norm': gain((DEPTH, D_MODEL)),
        'w_in_a': nrm((N_A, D_MODEL, IN_A), D_MODEL ** -0.5),
        'w_in_b': nrm((N_B, D_MODEL, IN_B), D_MODEL ** -0.5),
        'w_out': nrm((DEPTH, OUT_W, D_MODEL), OUT_W ** -0.5),
        'dn_conv_w': nrm((N_A, CONV_W, DN_CONV_CH), CONV_W ** -0.5),
        'dn_a_log': jnp.log(jax.random.uniform(sub(), (N_A, N_HEADS), F32, 1.0, 16.0)),
        'dn_dt_bias': dt + jnp.log(-jnp.expm1(-dt)),
        'dn_out_norm': gain((N_A, HEAD_DIM)),
        'kv_norm': gain((D_MODEL,)),
        'w_kv': nrm((D_MODEL, 2 * N_KV_B * HEAD_DIM), D_MODEL ** -0.5),
        'mem_norm': gain((DEPTH, D_MODEL)),
        'w_mem_kv': nrm((DEPTH, D_MODEL, 2 * MEM_W), D_MODEL ** -0.5),
        'ffn2_norm': gain((DEPTH, D_MODEL)),
        'ffn2_w1': nrm((DEPTH, D_MODEL, D_FF), D_MODEL ** -0.5),
        'ffn2_w3': nrm((DEPTH, D_MODEL, D_FF), D_MODEL ** -0.5),
        'ffn2_w2': nrm((DEPTH, D_FF, D_MODEL), D_FF ** -0.5),
        'final_norm': gain((D_MODEL,)),
    }


def reference(x_prompt, x_sample, mem_prompt, cache_mem_k, cache_mem_v, state_dn_conv, state_dn_S,
              cache_kv_k, cache_kv_v, page_table,
              ffn1_norm, ffn1_w1, ffn1_w3, ffn1_w2, mix_norm, w_in_a, w_in_b, w_out,
              dn_conv_w, dn_a_log, dn_dt_bias, dn_out_norm, kv_norm, w_kv, mem_norm, w_mem_kv,
              ffn2_norm, ffn2_w1, ffn2_w3, ffn2_w2, final_norm):
    p = dict(ffn1_norm=ffn1_norm, ffn1_w1=ffn1_w1, ffn1_w3=ffn1_w3, ffn1_w2=ffn1_w2,
             mix_norm=mix_norm, w_in_a=w_in_a, w_in_b=w_in_b, w_out=w_out,
             dn_conv_w=dn_conv_w, dn_a_log=dn_a_log, dn_dt_bias=dn_dt_bias, dn_out_norm=dn_out_norm,
             kv_norm=kv_norm, w_kv=w_kv,
             ffn2_norm=ffn2_norm, ffn2_w1=ffn2_w1, ffn2_w3=ffn2_w3, ffn2_w2=ffn2_w2,
             final_norm=final_norm)
    Bp, Lp, _ = x_prompt.shape
    mkv = [mem_kv(mem_prompt, mem_norm[l], w_mem_kv[l]) for l in range(DEPTH)]
    mem_k_p = jnp.stack([t[0] for t in mkv])
    mem_v_p = jnp.stack([t[1] for t in mkv])
    conv0 = jnp.zeros((N_A, Bp, CONV_W - 1, DN_CONV_CH), x_prompt.dtype)
    s0 = jnp.zeros((N_A, Bp, N_HEADS, HEAD_DIM, HEAD_DIM), x_prompt.dtype)
    pos_p = jnp.arange(Lp, dtype=jnp.int32)
    y_prompt, conv_p, s_p, k_p, v_p = run_trunk(p, x_prompt, pos_p, mem_k_p, mem_v_p, conv0, s0, None, None)
    Bs, Ls, _ = x_sample.shape
    n_pages = page_table.shape[1]
    past_len = n_pages * cache_kv_k.shape[1]
    past_k = cache_kv_k[page_table].reshape(Bs, past_len, N_KV_B, HEAD_DIM)
    past_v = cache_kv_v[page_table].reshape(Bs, past_len, N_KV_B, HEAD_DIM)
    pos_s = past_len + jnp.arange(Ls, dtype=jnp.int32)
    y_sample, conv_s, s_s, k_s, v_s = run_trunk(p, x_sample, pos_s, cache_mem_k, cache_mem_v,
                                                 state_dn_conv, state_dn_S, past_k, past_v)
    return (y_prompt, y_sample, conv_p, s_p, k_p, v_p, mem_k_p, mem_v_p, conv_s, s_s, k_s, v_s)
```

```cpp
#include <hip/hip_runtime.h>
#include <hip/hip_cooperative_groups.h>
#include <cstdio>
#include <cstdint>
#include <cmath>
namespace cg = cooperative_groups;

constexpr int D = 1024, NB = 2, T = 8192, MP = NB * T;
constexpr int SB = 32, ST = 4, MS = SB * ST, MV = MP + MS;
constexpr int MT = 16640;
constexpr int FF = 2816, NH = 12, HD = 64, MIXW = 768, MEMW = 256, NMEM = 256, NKV = 4;
constexpr int QKVW = 2304, INA = 3352, INA_P = 3584, NUP = 5632, NUPKV = 6144;
constexpr int NPAGES = 64, PAGE = 128, NBLK = 32, BLK = 256, PAST = 8192;
constexpr float EPS = 1e-6f;

namespace pg8 {
#define PG8_LAS __attribute__((address_space(3)))
typedef unsigned short bf16_t;
typedef short bf16x8 __attribute__((ext_vector_type(8)));
typedef float f32x4 __attribute__((ext_vector_type(4)));
typedef unsigned u32x4 __attribute__((ext_vector_type(4)));
constexpr int BM = 256, BK = 64, HALF = 128, HTB = HALF * BK * 2  , STAGE_BYTES = 8 * HTB, NXCD = 8, WGM = 8;

__host__ __device__ __forceinline__ int lds_byte(int r, int c) { const int st = (r >> 4) * 2 + (c >> 5), rr = r & 15, cc = c & 31, ob = rr * 64 + cc * 2; return st * 1024 + (ob ^ (((ob >> 9) & 1) << 5)); }
__host__ __device__ __forceinline__ void stage_rc(int b, int& R, int& C) { const int st = b / 1024, sb = b % 1024, swz = sb ^ (((sb >> 9) & 1) << 5); R = (st >> 1) * 16 + swz / 64; C = (st & 1) * 32 + (swz % 64) / 2; }
__host__ __device__ __forceinline__ int perm32(int rho) { const int n = rho >> 4, i = rho & 15; return 8 * (i >> 2) + 4 * n + (i & 3); }

struct Unit { int pm, pn; };
struct Gemm { const bf16_t* A; const bf16_t* Bt; int M, N, K; };

struct StaticOrder {
    int nM, nN, nwg, G, c;
    __host__ __device__ void init(int M, int N, int G_, int c_) { nM = M / BM; nN = N / BM; nwg = nM * nN; G = G_; c = c_; }
    __host__ __device__ bool next(int i, Unit& u) const {
        const long L = (long)i * G + c; if (L >= nwg) return false;
        int wgid = (int)L; { const int q = nwg / NXCD, r = nwg % NXCD, xcd = wgid % NXCD, off = wgid / NXCD; wgid = (xcd < r ? xcd * (q + 1) : r * (q + 1) + (xcd - r) * q) + off; }
        const int nig = WGM * nN, gid = wgid / nig, fm = gid * WGM, gsz = (nM - fm) < WGM ? (nM - fm) : WGM;
        u.pm = fm + ((wgid % nig) % gsz); u.pn = (wgid % nig) / gsz; return true;
    }
    __device__ __forceinline__ void a_ready(const Unit&) const {}
    __device__ __forceinline__ void done(const Unit&) const {}
};

__device__ __forceinline__ unsigned cvt_pk_bf16(float lo, float hi) { unsigned r; asm volatile("v_cvt_pk_bf16_f32 %0, %1, %2" : "=v"(r) : "v"(lo), "v"(hi)); return r; }
typedef float f32x2 __attribute__((ext_vector_type(2)));

typedef unsigned u32x2 __attribute__((ext_vector_type(2)));
__device__ __forceinline__ float silu_f(float x) { return x * __builtin_amdgcn_rcpf(1.f + __expf(-x)); }
__device__ __forceinline__ float rstd_row(const float* ssq, int row) { return rsqrtf(ssq[row] * (1.f / 1024.f) + EPS); }
__device__ __forceinline__ int pos_of_row(int row) { return row < MP ? (row & (T - 1)) : PAST + ((row - MP) & 3); }
__device__ __forceinline__ u32x4 pack8(const float* v) { u32x4 w; w.x = cvt_pk_bf16(v[0], v[1]); w.y = cvt_pk_bf16(v[2], v[3]); w.z = cvt_pk_bf16(v[4], v[5]); w.w = cvt_pk_bf16(v[6], v[7]); return w; }
__device__ __forceinline__ void rope8(float* v, const float* rope, int row, int wc, int fq) {
    float pr[8];
#pragma unroll
    for (int j = 0; j < 8; ++j) pr[j] = __shfl_xor(v[j], 16);
    if ((wc & 1) == 0 && fq < 2) {
        const float* rp = rope + (size_t)pos_of_row(row) * 16;
        const f32x4 c0 = *(const f32x4*)(rp), c1 = *(const f32x4*)(rp + 4), s0 = *(const f32x4*)(rp + 8), s1 = *(const f32x4*)(rp + 12);
        const float cs[8] = {c0[0], c0[1], c0[2], c0[3], c1[0], c1[1], c1[2], c1[3]}, sn[8] = {s0[0], s0[1], s0[2], s0[3], s1[0], s1[1], s1[2], s1[3]};
        const float sg = fq == 0 ? -1.f : 1.f;
#pragma unroll
        for (int j = 0; j < 8; ++j) v[j] = v[j] * cs[j] + sg * pr[j] * sn[j];
    }
}

struct EpiUp {
    static constexpr bool PERM = true, AFTER_DRAIN = false;
    bf16_t* H; const float* ssq; int nff; float* kp; long vpofs; float* ks; long vsofs; const float* rope;
    __device__ __forceinline__ void operator()(const f32x4 (&acc)[2][2][4][2], const Unit& u, int wr, int wc, int fr, int fq) const {
        const int row0 = u.pm * BM + wr * 64 + fr;
        if (u.pn < nff) {
#pragma unroll
            for (int ai = 0; ai < 2; ++ai)
#pragma unroll
                for (int m = 0; m < 4; ++m) { const int row = row0 + ai * HALF + m * 16; const float rs = rstd_row(ssq, row);
                    float h[8];
#pragma unroll
                    for (int n = 0; n < 2; ++n)
#pragma unroll
                        for (int i = 0; i < 4; ++i) h[4 * n + i] = silu_f(acc[ai][0][m][n][i] * rs) * (acc[ai][1][m][n][i] * rs);
                    *(u32x4*)(H + (size_t)row * FF + u.pn * 128 + wc * 32 + fq * 8) = pack8(h); }
        } else {
            const bool isk = (u.pn == nff);
#pragma unroll
            for (int ai = 0; ai < 2; ++ai)
#pragma unroll
                for (int m = 0; m < 4; ++m) { const int row = row0 + ai * HALF + m * 16; const float rs = rstd_row(ssq, row);
#pragma unroll
                    for (int bj = 0; bj < 2; ++bj) { float v[8];
#pragma unroll
                        for (int n = 0; n < 2; ++n)
#pragma unroll
                            for (int i = 0; i < 4; ++i) v[4 * n + i] = acc[ai][bj][m][n][i] * rs;
                        if (isk) rope8(v, rope, row, wc, fq);
                        const int c = bj * HALF + wc * 32 + fq * 8;
                        float* dst = nullptr;
                        if (row < MP) dst = kp + (isk ? 0 : vpofs) + (size_t)row * 256 + c; else if (row < MV) dst = ks + (isk ? 0 : vsofs) + (size_t)(row - MP) * 256 + c;
                        if (dst) { *(f32x4*)dst = (f32x4){v[0], v[1], v[2], v[3]}; *(f32x4*)(dst + 4) = (f32x4){v[4], v[5], v[6], v[7]}; } } }
        }
    }
};

struct EpiResid {
    static constexpr bool PERM = false, AFTER_DRAIN = false;
    float* X; bf16_t* XB; float* ssq_out; float scale;
    __device__ __forceinline__ void operator()(const f32x4 (&acc)[2][2][4][2], const Unit& u, int wr, int wc, int fr, int fq) const {
        const int row0 = u.pm * BM + wr * 64 + fr, col0 = u.pn * BM + wc * 32 + 4 * fq;
#pragma unroll
        for (int ai = 0; ai < 2; ++ai)
#pragma unroll
            for (int m = 0; m < 4; ++m) { const int row = row0 + ai * HALF + m * 16; float ss = 0.f;
#pragma unroll
                for (int bj = 0; bj < 2; ++bj)
#pragma unroll
                    for (int n = 0; n < 2; ++n) { const size_t off = (size_t)row * D + col0 + bj * HALF + n * 16;
                        const f32x4 xo = *(const f32x4*)(X + off); const f32x4 xn = xo + acc[ai][bj][m][n] * scale;
                        *(f32x4*)(X + off) = xn; u32x2 w; w.x = cvt_pk_bf16(xn[0], xn[1]); w.y = cvt_pk_bf16(xn[2], xn[3]); *(u32x2*)(XB + off) = w;
                        ss += (xn[0] * xn[0] + xn[1] * xn[1]) + (xn[2] * xn[2] + xn[3] * xn[3]); }
                ss += __shfl_xor(ss, 16); ss += __shfl_xor(ss, 32);
                if (fq == 0) __hip_atomic_fetch_add(ssq_out + row, ss, __ATOMIC_RELAXED, __HIP_MEMORY_SCOPE_AGENT); }
    }
};

struct EpiInA {
    static constexpr bool PERM = true, AFTER_DRAIN = false;
    bf16_t* QKV; bf16_t* GATE; bf16_t* QMEM; float* GB; const float* ssq; float* convp; float* convs; const float* a_log; const float* dt_bias;
    __device__ __forceinline__ void operator()(const f32x4 (&acc)[2][2][4][2], const Unit& u, int wr, int wc, int fr, int fq) const {
        const int row0 = u.pm * BM + wr * 64 + fr;
#pragma unroll
        for (int ai = 0; ai < 2; ++ai)
#pragma unroll
            for (int m = 0; m < 4; ++m) { const int row = row0 + ai * HALF + m * 16; const float rs = rstd_row(ssq, row);
#pragma unroll
                for (int bj = 0; bj < 2; ++bj) { float v[8];
#pragma unroll
                    for (int n = 0; n < 2; ++n)
#pragma unroll
                        for (int i = 0; i < 4; ++i) v[4 * n + i] = acc[ai][bj][m][n][i] * rs;
                    const int c = u.pn * BM + bj * HALF + wc * 32 + fq * 8;
                    if (u.pn < 9) {
                        *(u32x4*)(QKV + (size_t)row * QKVW + c) = pack8(v);
                        float* dst = nullptr;
                        if (row < MP) { const int t = row & (T - 1); if (t >= T - 3) dst = convp + (size_t)((row >> 13) * 3 + (t - (T - 3))) * QKVW + c; }
                        else if (row < MV) { const int tt = (row - MP) & 3; if (tt >= 1) dst = convs + (size_t)(((row - MP) >> 2) * 3 + tt - 1) * QKVW + c; }
                        if (dst) { *(f32x4*)dst = (f32x4){v[0], v[1], v[2], v[3]}; *(f32x4*)(dst + 4) = (f32x4){v[4], v[5], v[6], v[7]}; }
                    } else if (u.pn < 12) {
#pragma unroll
                        for (int j = 0; j < 8; ++j) v[j] = silu_f(v[j]);
                        *(u32x4*)(GATE + (size_t)row * MIXW + (c - QKVW)) = pack8(v);
                    } else if (u.pn == 12) {
                        *(u32x4*)(QMEM + (size_t)row * MEMW + (c - 3072)) = pack8(v);
                    } else if (bj == 0 && wc == 0 && fq < 3) {
#pragma unroll
                        for (int j = 0; j < 8; ++j) { const int lc = fq * 8 + j;
                            float o;
                            if (lc < 12) { const float z = v[j] + dt_bias[lc]; const float sp = z > 20.f ? z : log1pf(__expf(z)); o = -__expf(a_log[lc]) * sp; }
                            else { o = __builtin_amdgcn_rcpf(1.f + __expf(-v[j])); }
                            GB[(size_t)row * 24 + lc] = o; }
                    } } }
    }
};

struct EpiInB {
    static constexpr bool PERM = true, AFTER_DRAIN = false;
    bf16_t* QB; bf16_t* QMEM; const float* ssq; const float* rope;
    __device__ __forceinline__ void operator()(const f32x4 (&acc)[2][2][4][2], const Unit& u, int wr, int wc, int fr, int fq) const {
        const int row0 = u.pm * BM + wr * 64 + fr;
#pragma unroll
        for (int ai = 0; ai < 2; ++ai)
#pragma unroll
            for (int m = 0; m < 4; ++m) { const int row = row0 + ai * HALF + m * 16; const float rs = rstd_row(ssq, row);
#pragma unroll
                for (int bj = 0; bj < 2; ++bj) { float v[8];
#pragma unroll
                    for (int n = 0; n < 2; ++n)
#pragma unroll
                        for (int i = 0; i < 4; ++i) v[4 * n + i] = acc[ai][bj][m][n][i] * rs;
                    const int c = bj * HALF + wc * 32 + fq * 8;
                    if (u.pn < 3) { rope8(v, rope, row, wc, fq); *(u32x4*)(QB + (size_t)row * MIXW + u.pn * BM + c) = pack8(v); }
                    else *(u32x4*)(QMEM + (size_t)row * MEMW + c) = pack8(v); } }
    }
};

struct EpiMem {
    static constexpr bool PERM = false, AFTER_DRAIN = false;
    float* mk; long vofs; const float* ssqm;
    __device__ __forceinline__ void operator()(const f32x4 (&acc)[2][2][4][2], const Unit& u, int wr, int wc, int fr, int fq) const {
        const int row0 = u.pm * BM + wr * 64 + fr, col0 = wc * 32 + 4 * fq;
        float* base = mk + (long)(u.pn & 1) * vofs + (size_t)(u.pn >> 1) * 512 * 256;
#pragma unroll
        for (int ai = 0; ai < 2; ++ai)
#pragma unroll
            for (int m = 0; m < 4; ++m) { const int row = row0 + ai * HALF + m * 16; const float rs = rstd_row(ssqm, row);
#pragma unroll
                for (int bj = 0; bj < 2; ++bj)
#pragma unroll
                    for (int n = 0; n < 2; ++n) *(f32x4*)(base + (size_t)row * 256 + col0 + bj * HALF + n * 16) = acc[ai][bj][m][n] * rs; }
    }
};

template <class Epi, class Sched, bool ALIGN_EPI = false, bool SP2 = false>
__device__ __forceinline__ void gemm_phase(PG8_LAS unsigned char* lds, const Gemm g, const Sched& S, const Epi& E) {
    const int tid = threadIdx.x, wid = __builtin_amdgcn_readfirstlane(tid >> 6), lane = tid & 63, wr = wid >> 2, wc = wid & 3, fr = lane & 15, fq = lane >> 4;
    const int K = g.K, nt = K / BK;
    unsigned voffA[2], voffB[2];
#pragma unroll
    for (int i = 0; i < 2; ++i) { int R, C; stage_rc(tid * 16 + i * 8192, R, C); const int Rb = Epi::PERM ? ((R & ~31) + perm32(R & 31)) : R;
        voffA[i] = (unsigned)(R * K + C) * 2u; voffB[i] = (unsigned)(Rb * K + C) * 2u; }
    const size_t kstep = (size_t)(BK * 2);
    const size_t hstep = (size_t)HALF * K * 2;
    const size_t tstep = 2 * hstep;
    const unsigned ldsw = (unsigned)wid * 1024u;
    const int aoff = lds_byte(wr * 64 + fr, fq * 8), boff = lds_byte(wc * 32 + fr, fq * 8);
#define PG8_SA(b, h) (((b) * 2 + (h)) * HTB)
#define PG8_SB(b, h) ((4 + (b) * 2 + (h)) * HTB)
#define PG8_STAGE(bufoff, gbase, voff) do { _Pragma("unroll") for (int _i = 0; _i < 2; ++_i) \
        __builtin_amdgcn_global_load_lds((const unsigned*)((const char*)(gbase) + (voff)[_i]), (PG8_LAS unsigned*)(lds + (bufoff) + ldsw + _i * 8192), 16, 0, 0); } while (0)
#define PG8_LDA(dst, b, h) do { _Pragma("unroll") for (int m = 0; m < 4; ++m) _Pragma("unroll") for (int k = 0; k < 2; ++k) dst[m][k] = *(const PG8_LAS bf16x8*)(lds + PG8_SA(b, h) + aoff + m * 2048 + k * 1024); } while (0)
#define PG8_LDB(dst, b, h) do { _Pragma("unroll") for (int n = 0; n < 2; ++n) _Pragma("unroll") for (int k = 0; k < 2; ++k) dst[n][k] = *(const PG8_LAS bf16x8*)(lds + PG8_SB(b, h) + boff + n * 2048 + k * 1024); } while (0)
#define PG8_MMA(ai, bj, At, Bt) do { __builtin_amdgcn_s_setprio(1); _Pragma("unroll") for (int m = 0; m < 4; ++m) _Pragma("unroll") for (int n = 0; n < 2; ++n) _Pragma("unroll") for (int k = 0; k < 2; ++k) \
        acc[ai][bj][m][n] = __builtin_amdgcn_mfma_f32_16x16x32_bf16(Bt[n][k], At[m][k], acc[ai][bj][m][n], 0, 0, 0); __builtin_amdgcn_s_setprio(0); } while (0)
#define PG8_WAIT_V(n) asm volatile("s_waitcnt vmcnt(" #n ")" ::: "memory")
#define PG8_WAIT_L(n) asm volatile("s_waitcnt lgkmcnt(" #n ")" ::: "memory")
#define PG8_BAR __builtin_amdgcn_s_barrier()
#define PG8_SCHED __builtin_amdgcn_sched_barrier(0)
    Unit cur, nxt; int ui = 0;
    if (!S.next(0, cur)) return;
    f32x4 acc[2][2][4][2];
#pragma unroll
    for (int a = 0; a < 2; ++a)
#pragma unroll
        for (int b = 0; b < 2; ++b)
#pragma unroll
            for (int m = 0; m < 4; ++m)
#pragma unroll
                for (int n = 0; n < 2; ++n) acc[a][b][m][n] = (f32x4){0.f, 0.f, 0.f, 0.f};
    bf16x8 At[4][2], B0[2][2], B1[2][2];
    const char* cA = (const char*)g.A + (size_t)cur.pm * tstep; const char* cB = (const char*)g.Bt + (size_t)cur.pn * tstep;
    S.a_ready(cur);
    if constexpr (SP2) {
        PG8_STAGE(PG8_SB(0, 0), cB, voffB); PG8_STAGE(PG8_SB(0, 1), cB + hstep, voffB); PG8_STAGE(PG8_SA(0, 0), cA, voffA); PG8_STAGE(PG8_SA(0, 1), cA + hstep, voffA);
        if (wr == 1) PG8_BAR;
        PG8_WAIT_V(2); PG8_BAR;
        PG8_STAGE(PG8_SB(1, 0), cB + kstep, voffB); PG8_STAGE(PG8_SA(1, 0), cA + kstep, voffA); PG8_STAGE(PG8_SB(1, 1), cB + hstep + kstep, voffB);
        PG8_WAIT_V(6); PG8_BAR;
    } else {
        PG8_STAGE(PG8_SB(0, 0), cB, voffB); PG8_STAGE(PG8_SA(0, 0), cA, voffA); PG8_STAGE(PG8_SB(0, 1), cB + hstep, voffB); PG8_STAGE(PG8_SA(0, 1), cA + hstep, voffA);
        if (wr == 1) PG8_BAR;
        PG8_WAIT_V(4); PG8_BAR;
        PG8_STAGE(PG8_SB(1, 0), cB + kstep, voffB); PG8_STAGE(PG8_SA(1, 0), cA + kstep, voffA); PG8_STAGE(PG8_SB(1, 1), cB + hstep + kstep, voffB);
        PG8_WAIT_V(6); PG8_BAR;
    }
    for (;;) {
        const bool has_next = S.next(ui + 1, nxt);
        const char* nA = has_next ? (const char*)g.A + (size_t)nxt.pm * tstep : cA; const char* nB = has_next ? (const char*)g.Bt + (size_t)nxt.pn * tstep : cB;
        for (int t = 0; t < nt; t += 2) {
            const bool last = (t == nt - 2);
            const char* a1 = cA + (size_t)(t + 1) * kstep;
            const char* a2 = last ? nA : cA + (size_t)(t + 2) * kstep; const char* b2 = last ? nB : cB + (size_t)(t + 2) * kstep;
            const char* a3 = a2 + kstep; const char* b3 = b2 + kstep;
            if (last && has_next) S.a_ready(nxt);
            if constexpr (SP2) {
            PG8_LDB(B0, 0, 0); PG8_LDB(B1, 0, 1); PG8_SCHED; PG8_LDA(At, 0, 0); PG8_STAGE(PG8_SA(1, 1), a1 + hstep, voffA);
            PG8_WAIT_V(8); PG8_WAIT_L(0); PG8_BAR; PG8_MMA(0, 0, At, B0); PG8_MMA(0, 1, At, B1); PG8_BAR; PG8_SCHED;
            PG8_LDA(At, 0, 1); PG8_STAGE(PG8_SB(0, 0), b2, voffB); PG8_STAGE(PG8_SB(0, 1), b2 + hstep, voffB); PG8_STAGE(PG8_SA(0, 0), a2, voffA);
            PG8_WAIT_V(8); PG8_WAIT_L(0); PG8_BAR; PG8_MMA(1, 0, At, B0); PG8_MMA(1, 1, At, B1); PG8_BAR; PG8_SCHED;
            PG8_LDB(B0, 1, 0); PG8_LDB(B1, 1, 1); PG8_SCHED; PG8_LDA(At, 1, 0); PG8_STAGE(PG8_SA(0, 1), a2 + hstep, voffA);
            PG8_WAIT_V(8); PG8_WAIT_L(0); PG8_BAR; PG8_MMA(0, 0, At, B0); PG8_MMA(0, 1, At, B1); PG8_BAR; PG8_SCHED;
            PG8_LDA(At, 1, 1); PG8_STAGE(PG8_SB(1, 0), b3, voffB); PG8_STAGE(PG8_SB(1, 1), b3 + hstep, voffB); PG8_STAGE(PG8_SA(1, 0), a3, voffA);
            PG8_WAIT_V(8); PG8_WAIT_L(0); PG8_BAR; PG8_MMA(1, 0, At, B0); PG8_MMA(1, 1, At, B1); PG8_BAR; PG8_SCHED;
            } else {
            PG8_LDB(B0, 0, 0); PG8_SCHED; PG8_LDA(At, 0, 0); PG8_STAGE(PG8_SA(1, 1), a1 + hstep, voffA);
            PG8_WAIT_L(8); PG8_BAR; PG8_WAIT_L(0); PG8_MMA(0, 0, At, B0); PG8_BAR; PG8_SCHED;
            PG8_LDB(B1, 0, 1); PG8_STAGE(PG8_SB(0, 0), b2, voffB);
            PG8_BAR; PG8_WAIT_L(0); PG8_MMA(0, 1, At, B1); PG8_BAR;
            PG8_LDA(At, 0, 1); PG8_STAGE(PG8_SA(0, 0), a2, voffA);
            PG8_BAR; PG8_WAIT_L(0); PG8_MMA(1, 0, At, B0); PG8_BAR; PG8_SCHED;
            PG8_STAGE(PG8_SB(0, 1), b2 + hstep, voffB);
            PG8_WAIT_V(6); PG8_BAR; PG8_MMA(1, 1, At, B1); PG8_BAR;
            PG8_LDB(B0, 1, 0); PG8_SCHED; PG8_LDA(At, 1, 0); PG8_STAGE(PG8_SA(0, 1), a2 + hstep, voffA);
            PG8_WAIT_L(8); PG8_BAR; PG8_WAIT_L(0); PG8_MMA(0, 0, At, B0); PG8_BAR; PG8_SCHED;
            PG8_LDB(B1, 1, 1); PG8_STAGE(PG8_SB(1, 0), b3, voffB);
            PG8_BAR; PG8_WAIT_L(0); PG8_MMA(0, 1, At, B1); PG8_BAR;
            PG8_LDA(At, 1, 1); PG8_STAGE(PG8_SA(1, 0), a3, voffA);
            PG8_BAR; PG8_WAIT_L(0); PG8_MMA(1, 0, At, B0); PG8_BAR; PG8_SCHED;
            PG8_STAGE(PG8_SB(1, 1), b3 + hstep, voffB);
            PG8_WAIT_V(6); PG8_BAR; PG8_MMA(1, 1, At, B1); PG8_BAR;
            }
        }
        if constexpr (ALIGN_EPI) { if (wr == 0) PG8_BAR; }
        if constexpr (!Epi::AFTER_DRAIN) { E(acc, cur, wr, wc, fr, fq); S.done(cur); }
        if (!has_next) break;
#pragma unroll
        for (int a = 0; a < 2; ++a)
#pragma unroll
            for (int b = 0; b < 2; ++b)
#pragma unroll
                for (int m = 0; m < 4; ++m)
#pragma unroll
                    for (int n = 0; n < 2; ++n) acc[a][b][m][n] = (f32x4){0.f, 0.f, 0.f, 0.f};
        cur = nxt; cA = nA; cB = nB; ++ui;
        if constexpr (ALIGN_EPI) { if (wr == 1) PG8_BAR; }
    }
    PG8_WAIT_V(0);
    if constexpr (!ALIGN_EPI) { if (wr == 0) PG8_BAR; }
    PG8_BAR;
    if constexpr (Epi::AFTER_DRAIN) { E.fused(acc, cur, wr, wc, fr, fq, lds, wid, lane); S.done(cur); }
#undef PG8_SA
#undef PG8_SB
#undef PG8_STAGE
#undef PG8_LDA
#undef PG8_LDB
#undef PG8_MMA
#undef PG8_WAIT_V
#undef PG8_WAIT_L
#undef PG8_BAR
#undef PG8_SCHED
}
}

#define GAS __attribute__((address_space(1)))
#define LAS __attribute__((address_space(3)))
typedef unsigned short bf16;
typedef unsigned v4u __attribute__((ext_vector_type(4)));
typedef float f32x4 __attribute__((ext_vector_type(4)));
#define RLX_AGENT __ATOMIC_RELAXED, __HIP_MEMORY_SCOPE_AGENT
#define LDS_WAIT() asm volatile("s_waitcnt lgkmcnt(0)" ::: "memory")
__device__ __forceinline__ unsigned f2bf(float f) { unsigned u = __builtin_bit_cast(unsigned, f); return (u + 0x7fffu + ((u >> 16) & 1u)) >> 16; }
__device__ __forceinline__ unsigned pk2(float lo, float hi) { return f2bf(lo) | (f2bf(hi) << 16); }
__device__ __forceinline__ float bf2f(unsigned short u) { return __builtin_bit_cast(float, (unsigned)u << 16); }
__device__ __forceinline__ float wave_sum(float v) {
#pragma unroll
    for (int o = 32; o >= 1; o >>= 1) v += __shfl_xor(v, o);
    return v;
}
__device__ __forceinline__ float wave_max(float v) {
#pragma unroll
    for (int o = 32; o >= 1; o >>= 1) v = fmaxf(v, __shfl_xor(v, o));
    return v;
}
__device__ __forceinline__ float rdlane(float v, int l) { return __builtin_bit_cast(float, __builtin_amdgcn_readlane(__builtin_bit_cast(int, v), l)); }

#define XB_TMO      128
#define XB_XCNT(j)  (256  + 64 * (j))
#define XB_XSUB(j)  (1280 + 64 * (j))
#define XB_XGEN(j)  (2304 + 64 * (j))
#define XB_TOP      3328
#define XB_TOPGEN   3392
#define XCD_BAR_WORDS 3456
#define XB_SPIN_CAP (1u << 18)

__device__ __forceinline__ unsigned xb_ld(unsigned* p)              { return __hip_atomic_load(p, __ATOMIC_RELAXED, __HIP_MEMORY_SCOPE_AGENT); }
__device__ __forceinline__ unsigned xb_add(unsigned* p, unsigned v) { return __hip_atomic_fetch_add(p, v, __ATOMIC_RELAXED, __HIP_MEMORY_SCOPE_AGENT); }
__device__ __forceinline__ unsigned xb_xcc_id() { return (unsigned)__builtin_amdgcn_s_getreg((3 << 11) | 20) & 0xFu; }
#define XB_SPIN(cond, bar) do { unsigned _sp = 0; while (cond) { __builtin_amdgcn_s_sleep(1); \
    if ((++_sp & 255u) == 0u) { if (xb_ld(&(bar)[XB_TMO])) break; if (_sp > XB_SPIN_CAP) { atomicAdd(&(bar)[XB_TMO], 1u); break; } } } } while (0)

struct XcdBarrier {
    unsigned* bar; unsigned x;
    volatile LAS unsigned* st;
};

__device__ __forceinline__ XcdBarrier xcd_barrier_post(unsigned* bar, volatile LAS unsigned* st) {
    XcdBarrier b; b.bar = bar; b.x = xb_xcc_id(); b.st = st;
    if (threadIdx.x == 0) (void)xb_add(&bar[XB_XCNT(b.x)], 1u);
    return b;
}
__device__ __forceinline__ void xcd_barrier_complete(unsigned* bar, unsigned x, unsigned& nloc, unsigned& nx) {
    const unsigned G = gridDim.x * gridDim.y * gridDim.z;
    unsigned sum, cnt, mine, sp = 0u;
    for (;;) {
        sum = 0u; cnt = 0u; mine = 0u;
#pragma unroll
        for (unsigned j = 0; j < 16; ++j) { const unsigned c = xb_ld(&bar[XB_XCNT(j)]); sum += c; cnt += (c > 0u) ? 1u : 0u; mine = (j == x) ? c : mine; }
        if (sum == G) break;
        __builtin_amdgcn_s_sleep(1);
        if ((++sp & 255u) == 0u) { if (xb_ld(&bar[XB_TMO])) break; if (sp > XB_SPIN_CAP) { atomicAdd(&bar[XB_TMO], 1u); break; } }
    }
    nloc = mine > 0u ? mine : 1u; nx = cnt > 0u ? cnt : 1u;
}

__device__ __forceinline__ void xcd_barrier(const XcdBarrier& b) {
    asm volatile("s_waitcnt vmcnt(0)" ::: "memory");
    __syncthreads();
    if (threadIdx.x == 0) {
        unsigned* bar = b.bar;
        __builtin_amdgcn_s_waitcnt(0);
        unsigned nloc = b.st[0], nx = b.st[1];
        if (nloc == 0u) { xcd_barrier_complete(bar, b.x, nloc, nx); b.st[0] = nloc; b.st[1] = nx; }
        const unsigned old = xb_add(&bar[XB_XSUB(b.x)], 1u);
        const unsigned gen = old / nloc;
        if (old + 1u == (gen + 1u) * nloc) {
            __builtin_amdgcn_fence(__ATOMIC_RELEASE, "agent");
            asm volatile("s_waitcnt vmcnt(0)" ::: "memory");
            const unsigned og = xb_add(&bar[XB_TOP], 1u);
            const unsigned tg = og / nx;
            if (og + 1u == (tg + 1u) * nx) xb_add(&bar[XB_TOPGEN], 1u);
            else XB_SPIN(xb_ld(&bar[XB_TOPGEN]) == tg, bar);
            __builtin_amdgcn_fence(__ATOMIC_ACQUIRE, "agent");
            xb_add(&bar[XB_XGEN(b.x)], 1u);
            asm volatile("s_waitcnt vmcnt(0)" ::: "memory");
        } else {
            XB_SPIN(xb_ld(&bar[XB_XGEN(b.x)]) == gen, bar);
            __builtin_amdgcn_fence(__ATOMIC_ACQUIRE, "agent");
            asm volatile("s_waitcnt vmcnt(0)" ::: "memory");
        }
    }
    __syncthreads();
}

constexpr size_t MiB = 1u << 20;
constexpr size_t al1(size_t x) { return (x + MiB - 1) / MiB * MiB; }
constexpr size_t WS_CTL = 0, CTL_ZERO_BYTES = 1 * MiB;
constexpr size_t SZ_W13 = al1((size_t)NUPKV * D * 2), SZ_W2T = al1((size_t)D * FF * 2);
constexpr size_t WS_W13 = 1 * MiB;
constexpr size_t WS_W2T = WS_W13 + 4 * SZ_W13;
constexpr size_t WS_WINA = WS_W2T + 4 * SZ_W2T;
constexpr size_t WS_WINB = WS_WINA + al1((size_t)INA_P * D * 2);
constexpr size_t WS_WOUT = WS_WINB + 2 * MiB;
constexpr size_t WS_WMEM = WS_WOUT + 4 * MiB;
constexpr size_t WS_X = WS_WMEM + 2 * MiB;
constexpr size_t WS_XB = WS_X + al1((size_t)MT * D * 4);
constexpr size_t WS_H = WS_XB + al1((size_t)MT * D * 2);
constexpr size_t WS_QKV = WS_H + al1((size_t)MT * FF * 2);
constexpr size_t WS_GATE = WS_QKV + al1((size_t)MT * QKVW * 2);
constexpr size_t WS_QMEM = WS_GATE + al1((size_t)MT * MIXW * 2);
constexpr size_t WS_GB = WS_QMEM + al1((size_t)MT * MEMW * 2);
constexpr size_t WS_MIX = WS_GB + al1((size_t)MT * 24 * 4);
constexpr size_t WS_QB = WS_MIX + al1((size_t)MT * D * 2);
constexpr size_t WS_SSQ = WS_QB + al1((size_t)MT * MIXW * 2);
constexpr size_t WS_MEMB = WS_SSQ + al1((size_t)8 * MT * 4);
constexpr size_t WS_SSQM = WS_MEMB + 1 * MiB;
constexpr size_t WS_ROPE = WS_SSQM + 1 * MiB;
constexpr size_t WS_KBP = WS_ROPE + 1 * MiB;
constexpr size_t WS_KBS = WS_KBP + 1 * MiB;
constexpr size_t WS_END = WS_KBS + 2 * MiB;

constexpr size_t O_YP = 0, O_YS = O_YP + (size_t)MP * D, O_CONVP = O_YS + (size_t)MS * D, O_SP = O_CONVP + (size_t)NB * 3 * QKVW, O_KP = O_SP + (size_t)NB * NH * 4096,
                 O_VP = O_KP + (size_t)MP * 256, O_MKP = O_VP + (size_t)MP * 256, O_MVP = O_MKP + (size_t)2 * 512 * 256, O_CONVS = O_MVP + (size_t)2 * 512 * 256,
                 O_SS = O_CONVS + (size_t)SB * 3 * QKVW, O_KS = O_SS + (size_t)SB * NH * 4096, O_VS = O_KS + (size_t)MS * 256, O_END = O_VS + (size_t)MS * 256;

constexpr int RING_OFF = 0, RING_BYTES = 131072;
constexpr int LDSCTL_OFF = RING_BYTES, MISC_OFF = LDSCTL_OFF + 320;
constexpr int LDS_BYTES = 147456;
constexpr int NWAVES = 8;
constexpr int CW_BAR = 4096;

enum InIdx { I_XP = 0, I_XS, I_MEMP, I_CMK, I_CMV, I_SCONV, I_SS, I_CKK, I_CKV, I_PT, I_F1N, I_F1W1, I_F1W3, I_F1W2, I_MIXN, I_WINA, I_WINB, I_WOUT, I_CONVW, I_ALOG, I_DTB, I_ONORM,
             I_KVN, I_WKV, I_MEMN, I_WMEMKV, I_F2N, I_F2W1, I_F2W3, I_F2W2, I_FINN, N_IN };

struct Args { const void* in[N_IN]; float* out; unsigned char* ws; int ph_lo, ph_hi, mode, pad; };

struct Frame {
    LAS unsigned char* lds;
    int tid, lane, wave, G;
    const Args* a;
};

template <class RM>
__device__ __forceinline__ void p0_item(const float* W, int K, int N, const float* gain, bf16* WT, RM rm, LAS float* scr, int item, int lane) {
    const int nblk = (N + 31) / 32, kb = item / nblk, nb = item % nblk, k0 = 64 * kb, n0 = 32 * nb;
    const int nn = n0 + (lane & 31); const bool ok = nn < N;
#pragma unroll 8
    for (int i = 0; i < 32; ++i) { const int kk = 2 * i + (lane >> 5); float v = ok ? W[(size_t)(k0 + kk) * N + nn] : 0.f; if (gain) v *= gain[k0 + kk]; scr[kk * 33 + (lane & 31)] = v; }
    LDS_WAIT(); asm volatile("" ::: "memory");
    const int c = lane & 7;
#pragma unroll
    for (int j = 0; j < 4; ++j) { const int n = (lane >> 3) + 8 * j; const LAS float* s = scr + (8 * c) * 33 + n;
        v4u o; o.x = pk2(s[0 * 33], s[1 * 33]); o.y = pk2(s[2 * 33], s[3 * 33]); o.z = pk2(s[4 * 33], s[5 * 33]); o.w = pk2(s[6 * 33], s[7 * 33]);
        if (n0 + n < N) *(v4u*)(WT + (size_t)rm(n0 + n) * K + k0 + 8 * c) = o; }
    LDS_WAIT(); asm volatile("" ::: "memory");
}
struct RmOff { int off; __device__ __forceinline__ int operator()(int n) const { return off + n; } };
struct RmIl { int half; __device__ __forceinline__ int operator()(int n) const { return (n >> 7) * 256 + half * 128 + (n & 127); } };
struct RmInA { __device__ __forceinline__ int operator()(int n) const { return n < 3072 ? n : (n < 3096 ? 3328 + (n - 3072) : 3072 + (n - 3096)); } };

__device__ __forceinline__ void p0_prologue(const Frame& F) {
    const Args& A = *F.a; unsigned char* ws = A.ws;
    LAS float* scr = (LAS float*)(F.lds + RING_OFF + F.wave * 16384);
    const int gw = blockIdx.x * NWAVES + F.wave, NGW = F.G * NWAVES, lane = F.lane;
    constexpr int IT_UP = (D / 64) * (FF / 32), IT_DN = (FF / 64) * (D / 32), IT_INA = (D / 64) * ((INA + 31) / 32), IT_SQ = (D / 64) * (D / 32), IT_HALF = (D / 64) * (512 / 32);
    constexpr int NJOB = 19;
    for (int job = 0; job < NJOB; ++job) {
        int nit;
        if (job < 12) nit = (job % 3 == 2) ? IT_DN : IT_UP; else if (job == 12) nit = IT_INA; else if (job < 16) nit = IT_SQ; else nit = IT_HALF;
        for (int it = gw; it < nit; it += NGW) {
            if (job < 12) { const int lf = job / 3, l = lf >> 1, f = lf & 1, w = job % 3;
                const float* nrm = (const float*)A.in[f ? I_F2N : I_F1N] + l * D;
                bf16* w13 = (bf16*)(ws + WS_W13 + (size_t)lf * SZ_W13); bf16* w2t = (bf16*)(ws + WS_W2T + (size_t)lf * SZ_W2T);
                if (w == 0) p0_item((const float*)A.in[f ? I_F2W1 : I_F1W1] + (size_t)l * D * FF, D, FF, nrm, w13, RmIl{0}, scr, it, lane);
                else if (w == 1) p0_item((const float*)A.in[f ? I_F2W3 : I_F1W3] + (size_t)l * D * FF, D, FF, nrm, w13, RmIl{1}, scr, it, lane);
                else p0_item((const float*)A.in[f ? I_F2W2 : I_F1W2] + (size_t)l * FF * D, FF, D, nullptr, w2t, RmOff{0}, scr, it, lane);
            } else if (job == 12) p0_item((const float*)A.in[I_WINA], D, INA, (const float*)A.in[I_MIXN], (bf16*)(ws + WS_WINA), RmInA{}, scr, it, lane);
            else if (job == 13) p0_item((const float*)A.in[I_WINB], D, D, (const float*)A.in[I_MIXN] + D, (bf16*)(ws + WS_WINB), RmOff{0}, scr, it, lane);
            else if (job == 14) p0_item((const float*)A.in[I_WOUT], D, D, nullptr, (bf16*)(ws + WS_WOUT), RmOff{0}, scr, it, lane);
            else if (job == 15) p0_item((const float*)A.in[I_WOUT] + (size_t)D * D, D, D, nullptr, (bf16*)(ws + WS_WOUT) + (size_t)D * D, RmOff{0}, scr, it, lane);
            else if (job == 16) p0_item((const float*)A.in[I_WKV], D, 512, (const float*)A.in[I_KVN], (bf16*)(ws + WS_W13 + (size_t)2 * SZ_W13), RmOff{NUP}, scr, it, lane);
            else if (job == 17) p0_item((const float*)A.in[I_WMEMKV], D, 512, (const float*)A.in[I_MEMN], (bf16*)(ws + WS_WMEM), RmOff{0}, scr, it, lane);
            else p0_item((const float*)A.in[I_WMEMKV] + (size_t)D * 512, D, 512, (const float*)A.in[I_MEMN] + D, (bf16*)(ws + WS_WMEM), RmOff{512}, scr, it, lane);
        }
    }
    float* X = (float*)(ws + WS_X); bf16* XB = (bf16*)(ws + WS_XB); float* SSQ = (float*)(ws + WS_SSQ); bf16* MIX = (bf16*)(ws + WS_MIX);
    for (int m = gw; m < MT; m += NGW) {
        const float* src = m < MP ? (const float*)A.in[I_XP] + (size_t)m * D : (m < MV ? (const float*)A.in[I_XS] + (size_t)(m - MP) * D : nullptr);
        float s = 0.f;
#pragma unroll
        for (int j = 0; j < 4; ++j) { f32x4 v = src ? *((const f32x4*)src + 64 * j + lane) : (f32x4){0.f, 0.f, 0.f, 0.f};
            *((f32x4*)(X + (size_t)m * D) + 64 * j + lane) = v; s += (v[0] * v[0] + v[1] * v[1]) + (v[2] * v[2] + v[3] * v[3]);
            *((unsigned long long*)(XB + (size_t)m * D) + 64 * j + lane) = (unsigned long long)pk2(v[0], v[1]) | ((unsigned long long)pk2(v[2], v[3]) << 32);
            if (m >= MV) *((unsigned long long*)(MIX + (size_t)m * D) + 64 * j + lane) = 0ull; }
        s = wave_sum(s);
        if (lane < 8) SSQ[(size_t)lane * MT + m] = lane == 0 ? s : 0.f;
    }
    bf16* MEMB = (bf16*)(ws + WS_MEMB); float* SSQM = (float*)(ws + WS_SSQM);
    for (int m = gw; m < 512; m += NGW) { const float* src = (const float*)A.in[I_MEMP] + (size_t)m * D; float s = 0.f;
#pragma unroll
        for (int j = 0; j < 4; ++j) { const f32x4 v = *((const f32x4*)src + 64 * j + lane); s += (v[0] * v[0] + v[1] * v[1]) + (v[2] * v[2] + v[3] * v[3]);
            *((unsigned long long*)(MEMB + (size_t)m * D) + 64 * j + lane) = (unsigned long long)pk2(v[0], v[1]) | ((unsigned long long)pk2(v[2], v[3]) << 32); }
        s = wave_sum(s); if (lane == 0) SSQM[m] = s; }
    float* ROPE = (float*)(ws + WS_ROPE);
    for (int i = blockIdx.x * (NWAVES * 64) + F.tid; i < (PAST + ST) * 8; i += F.G * NWAVES * 64) { const int pos = i >> 3, k = i & 7;
        const double inv = pow(500000.0, -(double)k / 8.0), ang = (double)pos * inv; ROPE[pos * 16 + k] = (float)cos(ang); ROPE[pos * 16 + 8 + k] = (float)sin(ang); }
}

__device__ __forceinline__ void dn_scan_seq(const Frame& F, int row0, int L, int h, const float* conv0, const float* S0, float* Sout) {
    const Args& A = *F.a; unsigned char* ws = A.ws; const int lane = F.lane;
    const bf16* QKV = (const bf16*)(ws + WS_QKV); const bf16* GATE = (const bf16*)(ws + WS_GATE); const float* GB = (const float*)(ws + WS_GB); bf16* MIX = (bf16*)(ws + WS_MIX);
    const float* cw = (const float*)A.in[I_CONVW]; const int cq = h * 64 + lane;
    float wq[4], wk[4], wv[4];
#pragma unroll
    for (int j = 0; j < 4; ++j) { wq[j] = cw[j * QKVW + cq]; wk[j] = cw[j * QKVW + 768 + cq]; wv[j] = cw[j * QKVW + 1536 + cq]; }
    float q1 = 0.f, q2 = 0.f, q3 = 0.f, k1 = 0.f, k2 = 0.f, k3 = 0.f, v1 = 0.f, v2 = 0.f, v3 = 0.f;
    if (conv0) { q3 = conv0[cq]; q2 = conv0[QKVW + cq]; q1 = conv0[2 * QKVW + cq]; k3 = conv0[768 + cq]; k2 = conv0[QKVW + 768 + cq]; k1 = conv0[2 * QKVW + 768 + cq];
                 v3 = conv0[1536 + cq]; v2 = conv0[QKVW + 1536 + cq]; v1 = conv0[2 * QKVW + 1536 + cq]; }
    float S[64];
#pragma unroll
    for (int d = 0; d < 64; ++d) S[d] = S0 ? S0[d * 64 + lane] : 0.f;
    const float onorm = ((const float*)A.in[I_ONORM])[lane];
    unsigned short nq[4], nk[4], nv[4], ngt[4]; float ng[4], nb[4];
#define DN_LOAD(t0) do { _Pragma("unroll") for (int i = 0; i < 4; ++i) { const size_t r = (size_t)(row0 + (t0) + i); nq[i] = QKV[r * QKVW + cq]; nk[i] = QKV[r * QKVW + 768 + cq]; nv[i] = QKV[r * QKVW + 1536 + cq]; \
        ngt[i] = GATE[r * MIXW + cq]; ng[i] = GB[r * 24 + h]; nb[i] = GB[r * 24 + 12 + h]; } } while (0)
    DN_LOAD(0);
    for (int t = 0; t < L; t += 4) {
        unsigned short cqv[4], ckv[4], cvv[4], cgt[4]; float cg_[4], cb_[4];
#pragma unroll
        for (int i = 0; i < 4; ++i) { cqv[i] = nq[i]; ckv[i] = nk[i]; cvv[i] = nv[i]; cgt[i] = ngt[i]; cg_[i] = ng[i]; cb_[i] = nb[i]; }
        { const int tn = (t + 4 < L) ? t + 4 : t; DN_LOAD(tn); }
#pragma unroll
        for (int i = 0; i < 4; ++i) {
            const float uq = bf2f(cqv[i]), uk = bf2f(ckv[i]), uv = bf2f(cvv[i]);
            const float yq = wq[0] * q3 + wq[1] * q2 + wq[2] * q1 + wq[3] * uq, yk = wk[0] * k3 + wk[1] * k2 + wk[2] * k1 + wk[3] * uk, yv = wv[0] * v3 + wv[1] * v2 + wv[2] * v1 + wv[3] * uv;
            q3 = q2; q2 = q1; q1 = uq; k3 = k2; k2 = k1; k1 = uk; v3 = v2; v2 = v1; v1 = uv;
            const float fq = pg8::silu_f(yq), fk = pg8::silu_f(yk), fv = pg8::silu_f(yv);
            const float sq = wave_sum(fq * fq), sk = wave_sum(fk * fk);
            const float qn = fq * rsqrtf(sq + EPS) * 0.125f, kn = fk * rsqrtf(sk + EPS);
            const float a = __expf(cg_[i]), beta = cb_[i];
            float kS = 0.f;
#pragma unroll
            for (int d = 0; d < 64; ++d) kS += rdlane(kn, d) * S[d];
            float kn2 = kn; asm volatile("" : "+v"(kn2));
            const float delta = beta * (fv - a * kS);
            float o = 0.f;
#pragma unroll
            for (int d = 0; d < 64; ++d) { S[d] = a * S[d] + rdlane(kn2, d) * delta; o += rdlane(qn, d) * S[d]; }
            const float ms = wave_sum(o * o) * (1.f / 64.f);
            const float ov = o * rsqrtf(ms + EPS) * onorm * bf2f(cgt[i]);
            MIX[(size_t)(row0 + t + i) * D + cq] = (bf16)f2bf(ov);
            __builtin_amdgcn_sched_barrier(0);
        }
    }
#undef DN_LOAD
#pragma unroll
    for (int d = 0; d < 64; ++d) Sout[d * 64 + lane] = S[d];
}

__device__ __forceinline__ void attn_seg(const float (&q)[64], const float* Kp, const float* Vp, int stride, int nk, float& m, float& l, float& o, int lane) {
    float s[4];
#pragma unroll
    for (int i = 0; i < 4; ++i) { const int key = i * 64 + lane; float a = -INFINITY;
        if (key < nk) { const f32x4* kr = (const f32x4*)(Kp + (size_t)key * stride); a = 0.f;
#pragma unroll
            for (int j = 0; j < 16; ++j) { const f32x4 kv = kr[j]; a += (q[4 * j] * kv[0] + q[4 * j + 1] * kv[1]) + (q[4 * j + 2] * kv[2] + q[4 * j + 3] * kv[3]); } }
        s[i] = a; }
    const float mx = wave_max(fmaxf(fmaxf(s[0], s[1]), fmaxf(s[2], s[3])));
    const float mn = fmaxf(m, mx), corr = __expf(m - mn);
    float p[4], ps = 0.f;
#pragma unroll
    for (int i = 0; i < 4; ++i) { p[i] = (s[i] == -INFINITY) ? 0.f : __expf(s[i] - mn); ps += p[i]; }
    l = l * corr + wave_sum(ps); o *= corr; m = mn;
#pragma unroll
    for (int i = 0; i < 4; ++i) { const int cnt = nk - i * 64 < 64 ? nk - i * 64 : 64;
        if (cnt > 0) { const float* vp = Vp + (size_t)(i * 64) * stride + lane;
#pragma unroll 8
            for (int j = 0; j < cnt; ++j) o += rdlane(p[i], j) * vp[(size_t)j * stride]; } }
}

__device__ __forceinline__ void moba_task(const Frame& F, int row, int h) {
    const Args& A = *F.a; unsigned char* ws = A.ws; const int lane = F.lane, g = h / 3;
    const bf16* QB = (const bf16*)(ws + WS_QB); bf16* MIX = (bf16*)(ws + WS_MIX);
    const float qv = bf2f(QB[(size_t)row * MIXW + h * 64 + lane]) * 0.125f;
    float q[64];
#pragma unroll
    for (int d = 0; d < 64; ++d) q[d] = rdlane(qv, d);
    float m = -INFINITY, l = 0.f, o = 0.f;
    const bool prompt = row < MP;
    const int b = prompt ? (row >> 13) : ((row - MP) >> 2), t = prompt ? (row & (T - 1)) : ((row - MP) & 3), qb = prompt ? (t >> 8) : NBLK;
    const float* kbar = prompt ? (const float*)(ws + WS_KBP) : (const float*)(ws + WS_KBS);
    float val = -INFINITY;
    if (lane < qb) { const f32x4* kr = (const f32x4*)(kbar + (size_t)((b * NBLK + lane) * NKV + g) * 64); float a = 0.f;
#pragma unroll
        for (int j = 0; j < 16; ++j) { const f32x4 kv = kr[j]; a += (q[4 * j] * kv[0] + q[4 * j + 1] * kv[1]) + (q[4 * j + 2] * kv[2] + q[4 * j + 3] * kv[3]); }
        val = a; }
    const float* KP = A.out + O_KP; const float* VP = A.out + O_VP; const float* KS = A.out + O_KS; const float* VS = A.out + O_VS;
    const float* CK = (const float*)A.in[I_CKK]; const float* CV = (const float*)A.in[I_CKV]; const int* PT = (const int*)A.in[I_PT];
    for (int r = 0; r < 3; ++r) {
        const float mx = wave_max(val);
        if (mx == -INFINITY) break;
        const unsigned long long bal = __ballot(val == mx); const int sel = __ffsll((long long)bal) - 1;
        if (lane == sel) val = -INFINITY;
        if (prompt) { const size_t off = (size_t)(b * T + sel * BLK) * 256 + g * 64; attn_seg(q, KP + off, VP + off, 256, BLK, m, l, o, lane); }
        else {
#pragma unroll 1
            for (int hf = 0; hf < 2; ++hf) { const int pg = PT[b * NPAGES + 2 * sel + hf]; const size_t off = ((size_t)pg * PAGE * NKV + g) * 64; attn_seg(q, CK + off, CV + off, 256, PAGE, m, l, o, lane); } }
    }
    if (prompt) { const size_t off = (size_t)(b * T + qb * BLK) * 256 + g * 64; attn_seg(q, KP + off, VP + off, 256, (t & (BLK - 1)) + 1, m, l, o, lane); }
    else { const size_t off = (size_t)(b * ST) * 256 + g * 64; attn_seg(q, KS + off, VS + off, 256, t + 1, m, l, o, lane); }
    MIX[(size_t)row * D + h * 64 + lane] = (bf16)f2bf(o / l);
}
__device__ __forceinline__ void mem_task(const Frame& F, int row, int j, int lyr) {
    const Args& A = *F.a; unsigned char* ws = A.ws; const int lane = F.lane;
    const bf16* QM = (const bf16*)(ws + WS_QMEM); bf16* MIX = (bf16*)(ws + WS_MIX);
    const float qv = bf2f(QM[(size_t)row * MEMW + j * 64 + lane]) * 0.125f;
    float q[64];
#pragma unroll
    for (int d = 0; d < 64; ++d) q[d] = rdlane(qv, d);
    float m = -INFINITY, l = 0.f, o = 0.f;
    const float *Kp, *Vp;
    if (row < MP) { const size_t off = (size_t)((lyr * 2 + (row >> 13)) * NMEM) * 256 + j * 64; Kp = A.out + O_MKP + off; Vp = A.out + O_MVP + off; }
    else { const size_t off = (size_t)((lyr * SB + ((row - MP) >> 2)) * NMEM) * 256 + j * 64; Kp = (const float*)A.in[I_CMK] + off; Vp = (const float*)A.in[I_CMV] + off; }
    attn_seg(q, Kp, Vp, 256, NMEM, m, l, o, lane);
    MIX[(size_t)row * D + MIXW + j * 64 + lane] = (bf16)f2bf(o / l);
}
__device__ __forceinline__ void kbar_task(const Frame& F, bool prompt, int b, int n, int g) {
    const Args& A = *F.a; const int lane = F.lane; float s = 0.f;
    if (prompt) { const float* kp = A.out + O_KP + (size_t)(b * T + n * BLK) * 256 + g * 64 + lane;
#pragma unroll 8
        for (int j = 0; j < BLK; ++j) s += kp[(size_t)j * 256];
        ((float*)(A.ws + WS_KBP))[(size_t)((b * NBLK + n) * NKV + g) * 64 + lane] = s * (1.f / BLK);
    } else { const int* PT = (const int*)A.in[I_PT];
#pragma unroll 1
        for (int hf = 0; hf < 2; ++hf) { const float* kp = (const float*)A.in[I_CKK] + ((size_t)PT[b * NPAGES + 2 * n + hf] * PAGE * NKV + g) * 64 + lane;
#pragma unroll 8
            for (int j = 0; j < PAGE; ++j) s += kp[(size_t)j * 256]; }
        ((float*)(A.ws + WS_KBS))[(size_t)((b * NBLK + n) * NKV + g) * 64 + lane] = s * (1.f / BLK);
    }
}

constexpr int N_PHASES = 16;
__global__ void __launch_bounds__(NWAVES * 64, 2) mk_fwd(Args args) {
    extern __shared__ __attribute__((aligned(16))) unsigned char lds[];
    Frame F;
    F.lds = (LAS unsigned char*)lds; F.tid = threadIdx.x; F.lane = F.tid & 63; F.wave = __builtin_amdgcn_readfirstlane(F.tid >> 6); F.G = gridDim.x; F.a = &args;
    unsigned char* ws = args.ws;
    volatile LAS unsigned* MISC = (volatile LAS unsigned*)(F.lds + MISC_OFF);
    for (int u = F.tid; u < (LDS_BYTES - LDSCTL_OFF) / 4; u += NWAVES * 64) ((LAS unsigned*)(F.lds + LDSCTL_OFF))[u] = 0u;
    __syncthreads();
    XcdBarrier bar; bar.bar = (unsigned*)(ws + WS_CTL) + CW_BAR; bar.x = 0; bar.st = nullptr;
    if (args.mode == 2) bar = xcd_barrier_post((unsigned*)(ws + WS_CTL) + CW_BAR, MISC + 8);
    const int lo = args.ph_lo, hi = args.ph_hi;
#ifndef PH_MASK
#define PH_MASK 0xffff
#endif
#define IN(k) ((((PH_MASK) >> (k)) & 1) && lo <= (k) && (k) < hi)
#define SEAM(k) do { if (IN(k) && IN((k) + 1)) { if (args.mode == 1 || (args.mode == 2 && (k) == 0)) cg::this_grid().sync(); else if (args.mode == 2) xcd_barrier(bar); } } while (0)
    LAS unsigned char* ring = F.lds + RING_OFF;
    bf16* XB = (bf16*)(ws + WS_XB); float* X = (float*)(ws + WS_X); bf16* HB = (bf16*)(ws + WS_H); float* SSQ = (float*)(ws + WS_SSQ); bf16* MIX = (bf16*)(ws + WS_MIX);
    const float* ROPE = (const float*)(ws + WS_ROPE);
    const int bx = (int)blockIdx.x, gw = bx * NWAVES + F.wave, NGW = F.G * NWAVES;

    if (IN(0)) { p0_prologue(F); } SEAM(0);

    if (IN(1)) {
        if (bx >= F.G - 8) { pg8::Gemm g{(const bf16*)(ws + WS_MEMB), (const bf16*)(ws + WS_WMEM), 512, D, D}; pg8::StaticOrder S; S.init(512, D, 8, bx - (F.G - 8));
            pg8::EpiMem E{args.out + O_MKP, (long)(O_MVP - O_MKP), (const float*)(ws + WS_SSQM)};
            pg8::gemm_phase<pg8::EpiMem, pg8::StaticOrder, true, true>(ring, g, S, E); }
        pg8::Gemm g{XB, (const bf16*)(ws + WS_W13), MT, NUP, D}; pg8::StaticOrder S; S.init(MT, NUP, F.G, bx);
        pg8::EpiUp E{HB, SSQ + 0 * MT, NUP / 256, nullptr, 0, nullptr, 0, ROPE};
        pg8::gemm_phase<pg8::EpiUp, pg8::StaticOrder, true, true>(ring, g, S, E);
    } SEAM(1);
    if (IN(2)) {
        pg8::Gemm g{HB, (const bf16*)(ws + WS_W2T), MT, D, FF}; pg8::StaticOrder S; S.init(MT, D, F.G, bx);
        pg8::EpiResid E{X, XB, SSQ + 1 * MT, 0.5f};
        pg8::gemm_phase<pg8::EpiResid, pg8::StaticOrder, true, true>(ring, g, S, E);
    } SEAM(2);
    if (IN(3)) {
        pg8::Gemm g{XB, (const bf16*)(ws + WS_WINA), MT, INA_P, D}; pg8::StaticOrder S; S.init(MT, INA_P, F.G, bx);
        pg8::EpiInA E{(bf16*)(ws + WS_QKV), (bf16*)(ws + WS_GATE), (bf16*)(ws + WS_QMEM), (float*)(ws + WS_GB), SSQ + 1 * MT, args.out + O_CONVP, args.out + O_CONVS,
                      (const float*)args.in[I_ALOG], (const float*)args.in[I_DTB]};
        pg8::gemm_phase<pg8::EpiInA, pg8::StaticOrder, true, true>(ring, g, S, E);
    } SEAM(3);
    if (IN(4)) {
        constexpr int NSCAN = NB * NH;
        const int w = (bx - NSCAN) * NWAVES + F.wave, NW = (F.G - NSCAN) * NWAVES;
        {
            int first, limit, step;
            if (bx < NSCAN) { first = (F.wave == 0) ? bx : 0; limit = (F.wave == 0) ? bx + 1 : 0; step = 1; } else { first = NSCAN + w; limit = NSCAN + SB * NH; step = NW; }
#if !defined(P4_SKIP_A)
            for (int it = first; it < limit; it += step) {
                const bool pr = it < NSCAN; const int sid = pr ? it : it - NSCAN, b = sid / NH, h = sid % NH;
                dn_scan_seq(F, pr ? b * T : MP + b * ST, pr ? T : ST, h, pr ? nullptr : (const float*)args.in[I_SCONV] + (size_t)b * 3 * QKVW, pr ? nullptr : (const float*)args.in[I_SS] + (size_t)sid * 4096,
                            args.out + (pr ? O_SP : O_SS) + (size_t)sid * 4096); }
#endif
        }
        if (bx >= NSCAN) {
#if !defined(P4_SKIP_B)
            for (int k = w; k < SB * NBLK * NKV; k += NW) kbar_task(F, false, k / (NBLK * NKV), (k / NKV) % NBLK, k % NKV);
#endif
#if !defined(P4_SKIP_C)
            for (int k = w; k < MV * 4; k += NW) mem_task(F, k >> 2, k & 3, 0);
#endif
        }
    } SEAM(4);
    if (IN(5)) {
        pg8::Gemm g{MIX, (const bf16*)(ws + WS_WOUT), MT, D, D}; pg8::StaticOrder S; S.init(MT, D, F.G, bx);
        pg8::EpiResid E{X, XB, SSQ + 2 * MT, 1.0f};
        pg8::gemm_phase<pg8::EpiResid, pg8::StaticOrder, true, true>(ring, g, S, E);
    } SEAM(5);
    if (IN(6)) {
        pg8::Gemm g{XB, (const bf16*)(ws + WS_W13 + 1 * SZ_W13), MT, NUP, D}; pg8::StaticOrder S; S.init(MT, NUP, F.G, bx);
        pg8::EpiUp E{HB, SSQ + 2 * MT, NUP / 256, nullptr, 0, nullptr, 0, ROPE};
        pg8::gemm_phase<pg8::EpiUp, pg8::StaticOrder, true, true>(ring, g, S, E);
    } SEAM(6);
    if (IN(7)) {
        pg8::Gemm g{HB, (const bf16*)(ws + WS_W2T + 1 * SZ_W2T), MT, D, FF}; pg8::StaticOrder S; S.init(MT, D, F.G, bx);
        pg8::EpiResid E{X, XB, SSQ + 3 * MT, 0.5f};
        pg8::gemm_phase<pg8::EpiResid, pg8::StaticOrder, true, true>(ring, g, S, E);
    } SEAM(7);
    if (IN(8)) {
        pg8::Gemm g{XB, (const bf16*)(ws + WS_W13 + 2 * SZ_W13), MT, NUPKV, D}; pg8::StaticOrder S; S.init(MT, NUPKV, F.G, bx);
        pg8::EpiUp E{HB, SSQ + 3 * MT, NUP / 256, args.out + O_KP, (long)(O_VP - O_KP), args.out + O_KS, (long)(O_VS - O_KS), ROPE};
        pg8::gemm_phase<pg8::EpiUp, pg8::StaticOrder, true, true>(ring, g, S, E);
    } SEAM(8);
    if (IN(9)) {
        for (int it = gw; it < NB * NBLK * NKV; it += NGW) kbar_task(F, true, it / (NBLK * NKV), (it / NKV) % NBLK, it % NKV);
        pg8::Gemm g{HB, (const bf16*)(ws + WS_W2T + 2 * SZ_W2T), MT, D, FF}; pg8::StaticOrder S; S.init(MT, D, F.G, bx);
        pg8::EpiResid E{X, XB, SSQ + 4 * MT, 0.5f};
        pg8::gemm_phase<pg8::EpiResid, pg8::StaticOrder, true, true>(ring, g, S, E);
    } SEAM(9);
    if (IN(10)) {
        pg8::Gemm g{XB, (const bf16*)(ws + WS_WINB), MT, D, D}; pg8::StaticOrder S; S.init(MT, D, F.G, bx);
        pg8::EpiInB E{(bf16*)(ws + WS_QB), (bf16*)(ws + WS_QMEM), SSQ + 4 * MT, ROPE};
        pg8::gemm_phase<pg8::EpiInB, pg8::StaticOrder, true, true>(ring, g, S, E);
    } SEAM(10);
    if (IN(11)) {
        for (int it = gw; it < MV * 16; it += NGW) { const int row = it >> 4, hh = it & 15; if (hh < NH) moba_task(F, row, hh); else mem_task(F, row, hh - NH, 1); }
    } SEAM(11);
    if (IN(12)) {
        pg8::Gemm g{MIX, (const bf16*)(ws + WS_WOUT) + (size_t)D * D, MT, D, D}; pg8::StaticOrder S; S.init(MT, D, F.G, bx);
        pg8::EpiResid E{X, XB, SSQ + 5 * MT, 1.0f};
        pg8::gemm_phase<pg8::EpiResid, pg8::StaticOrder, true, true>(ring, g, S, E);
    } SEAM(12);
    if (IN(13)) {
        pg8::Gemm g{XB, (const bf16*)(ws + WS_W13 + 3 * SZ_W13), MT, NUP, D}; pg8::StaticOrder S; S.init(MT, NUP, F.G, bx);
        pg8::EpiUp E{HB, SSQ + 5 * MT, NUP / 256, nullptr, 0, nullptr, 0, ROPE};
        pg8::gemm_phase<pg8::EpiUp, pg8::StaticOrder, true, true>(ring, g, S, E);
    } SEAM(13);
    if (IN(14)) {
        pg8::Gemm g{HB, (const bf16*)(ws + WS_W2T + 3 * SZ_W2T), MT, D, FF}; pg8::StaticOrder S; S.init(MT, D, F.G, bx);
        pg8::EpiResid E{X, XB, SSQ + 6 * MT, 0.5f};
        pg8::gemm_phase<pg8::EpiResid, pg8::StaticOrder, true, true>(ring, g, S, E);
    } SEAM(14);
    if (IN(15)) {
        const float* fg = (const float*)args.in[I_FINN]; const float* sq = SSQ + 6 * MT;
        for (int m = gw; m < MV; m += NGW) { const float rs = rsqrtf(sq[m] * (1.f / 1024.f) + EPS); float* dst = m < MP ? args.out + O_YP + (size_t)m * D : args.out + O_YS + (size_t)(m - MP) * D;
#pragma unroll
            for (int j = 0; j < 4; ++j) { const f32x4 v = *((const f32x4*)(X + (size_t)m * D) + 64 * j + F.lane); const f32x4 gv = *((const f32x4*)fg + 64 * j + F.lane);
                *((f32x4*)dst + 64 * j + F.lane) = v * rs * gv; } }
    }
#undef IN
#undef SEAM
}

#ifndef MK_MODE
#define MK_MODE 1
#endif
extern "C" void kernel_launch(void* const* d_in, const int* in_sizes, int n_in, void* d_out, int out_size, void* d_ws, size_t ws_size, hipStream_t stream) {
    static int grid = 0;
    if (grid == 0) {
        if (n_in != N_IN || (size_t)out_size != O_END || ws_size < WS_END) { fprintf(stderr, "kernel_launch: shape mismatch: n_in %d (want %d), out %d (want %zu), ws %zu (want >= %zu); nothing launched\n", n_in, (int)N_IN, out_size, (size_t)O_END, ws_size, (size_t)WS_END); grid = -1; return; }
        int dev = 0, cus = 0, per_cu = 0;
        if (hipGetDevice(&dev) != hipSuccess || hipDeviceGetAttribute(&cus, hipDeviceAttributeMultiprocessorCount, dev) != hipSuccess) { fprintf(stderr, "kernel_launch: device query failed\n"); grid = -1; return; }
        if (hipFuncSetAttribute((const void*)mk_fwd, hipFuncAttributeMaxDynamicSharedMemorySize, LDS_BYTES) != hipSuccess) { fprintf(stderr, "kernel_launch: hipFuncSetAttribute failed\n"); grid = -1; return; }
        if (hipOccupancyMaxActiveBlocksPerMultiprocessor(&per_cu, (const void*)mk_fwd, NWAVES * 64, LDS_BYTES) != hipSuccess || per_cu < 1) { fprintf(stderr, "kernel_launch: occupancy query says %d blocks per CU\n", per_cu); per_cu = 1; }
        (void)hipGetLastError();
        grid = cus;
        if (grid > 256) grid = 256;
        fprintf(stderr, "kernel_launch: grid %d (cus %d, occupancy %d per CU), mode %d\n", grid, cus, per_cu, (int)MK_MODE);
    }
    if (grid < 0) return;
    Args a{};
    for (int i = 0; i < N_IN; ++i) a.in[i] = d_in[i];
    a.out = (float*)d_out; a.ws = (unsigned char*)d_ws; a.mode = MK_MODE;
    if (MK_MODE == 0) {
        for (int p = 0; p < N_PHASES; ++p) { a.ph_lo = p; a.ph_hi = p + 1; hipLaunchKernelGGL(mk_fwd, dim3(grid), dim3(NWAVES * 64), LDS_BYTES, stream, a); }
    } else {
        if (MK_MODE == 2) (void)hipMemsetAsync((char*)d_ws + WS_CTL, 0, CTL_ZERO_BYTES, stream);
        a.ph_lo = 0; a.ph_hi = N_PHASES;
        void* kargs[] = {&a};
        hipError_t e = hipLaunchCooperativeKernel((const void*)mk_fwd, dim3(grid), dim3(NWAVES * 64), kargs, LDS_BYTES, stream);
        if (e != hipSuccess) fprintf(stderr, "kernel_launch: cooperative launch failed: %s (grid %d)\n", hipGetErrorString(e), grid);
    }
}
```

```cpp
#include <hip/hip_runtime.h>
#include <hip/hip_cooperative_groups.h>
#include <cstdio>
#include <cstdint>
#include <cmath>
namespace cg = cooperative_groups;

constexpr int D = 1024, NB = 2, T = 8192, MP = NB * T;
constexpr int SB = 32, ST = 4, MS = SB * ST, MV = MP + MS;
constexpr int MT = 16640;
constexpr int FF = 2816, NH = 12, HD = 64, MIXW = 768, MEMW = 256, NMEM = 256, NKV = 4;
constexpr int QKVW = 2304, INA = 3352, INA_P = 3584, NUP = 5632, NUPKV = 6144;
constexpr int NPAGES = 64, PAGE = 128, NBLK = 32, BLK = 256, PAST = 8192;
constexpr float EPS = 1e-6f;

namespace pg8 {
#define PG8_LAS __attribute__((address_space(3)))
typedef unsigned short bf16_t;
typedef short bf16x8 __attribute__((ext_vector_type(8)));
typedef float f32x4 __attribute__((ext_vector_type(4)));
typedef unsigned u32x4 __attribute__((ext_vector_type(4)));
constexpr int BM = 256, BK = 64, HALF = 128, HTB = HALF * BK * 2  , STAGE_BYTES = 8 * HTB, NXCD = 8, WGM = 8;

__host__ __device__ __forceinline__ int lds_byte(int r, int c) { const int st = (r >> 4) * 2 + (c >> 5), rr = r & 15, cc = c & 31, ob = rr * 64 + cc * 2; return st * 1024 + (ob ^ (((ob >> 9) & 1) << 5)); }
__host__ __device__ __forceinline__ void stage_rc(int b, int& R, int& C) { const int st = b / 1024, sb = b % 1024, swz = sb ^ (((sb >> 9) & 1) << 5); R = (st >> 1) * 16 + swz / 64; C = (st & 1) * 32 + (swz % 64) / 2; }
__host__ __device__ __forceinline__ int perm32(int rho) { const int n = rho >> 4, i = rho & 15; return 8 * (i >> 2) + 4 * n + (i & 3); }

struct Unit { int pm, pn; };
struct Gemm { const bf16_t* A; const bf16_t* Bt; int M, N, K; };

struct StaticOrder {
    int nM, nN, nwg, G, c;
    __host__ __device__ void init(int M, int N, int G_, int c_) { nM = M / BM; nN = N / BM; nwg = nM * nN; G = G_; c = c_; }
    __host__ __device__ bool next(int i, Unit& u) const {
        const long L = (long)i * G + c; if (L >= nwg) return false;
        int wgid = (int)L; { const int q = nwg / NXCD, r = nwg % NXCD, xcd = wgid % NXCD, off = wgid / NXCD; wgid = (xcd < r ? xcd * (q + 1) : r * (q + 1) + (xcd - r) * q) + off; }
        const int nig = WGM * nN, gid = wgid / nig, fm = gid * WGM, gsz = (nM - fm) < WGM ? (nM - fm) : WGM;
        u.pm = fm + ((wgid % nig) % gsz); u.pn = (wgid % nig) / gsz; return true;
    }
    __device__ __forceinline__ void a_ready(const Unit&) const {}
    __device__ __forceinline__ void done(const Unit&) const {}
};

__device__ __forceinline__ unsigned cvt_pk_bf16(float lo, float hi) { unsigned r; asm volatile("v_cvt_pk_bf16_f32 %0, %1, %2" : "=v"(r) : "v"(lo), "v"(hi)); return r; }
typedef float f32x2 __attribute__((ext_vector_type(2)));

typedef unsigned u32x2 __attribute__((ext_vector_type(2)));
__device__ __forceinline__ float silu_f(float x) { return x * __builtin_amdgcn_rcpf(1.f + __expf(-x)); }
__device__ __forceinline__ float ssq_row(const float* ssq, int row) { const f32x4* p = (const f32x4*)(ssq + (size_t)row * 16); const f32x4 a = p[0], b = p[1], c = p[2], d = p[3];
    return (((a[0] + a[1]) + (a[2] + a[3])) + ((b[0] + b[1]) + (b[2] + b[3]))) + (((c[0] + c[1]) + (c[2] + c[3])) + ((d[0] + d[1]) + (d[2] + d[3]))); }
__device__ __forceinline__ float rstd_row(const float* ssq, int row) { return rsqrtf(ssq_row(ssq, row) * (1.f / 1024.f) + EPS); }
__device__ __forceinline__ int pos_of_row(int row) { return row < MP ? (row & (T - 1)) : PAST + ((row - MP) & 3); }
__device__ __forceinline__ u32x4 pack8(const float* v) { u32x4 w; w.x = cvt_pk_bf16(v[0], v[1]); w.y = cvt_pk_bf16(v[2], v[3]); w.z = cvt_pk_bf16(v[4], v[5]); w.w = cvt_pk_bf16(v[6], v[7]); return w; }
__device__ __forceinline__ void rope8(float* v, const float* rope, int row, int wc, int fq) {
    float pr[8];
#pragma unroll
    for (int j = 0; j < 8; ++j) pr[j] = __shfl_xor(v[j], 16);
    if ((wc & 1) == 0 && fq < 2) {
        const float* rp = rope + (size_t)pos_of_row(row) * 16;
        const f32x4 c0 = *(const f32x4*)(rp), c1 = *(const f32x4*)(rp + 4), s0 = *(const f32x4*)(rp + 8), s1 = *(const f32x4*)(rp + 12);
        const float cs[8] = {c0[0], c0[1], c0[2], c0[3], c1[0], c1[1], c1[2], c1[3]}, sn[8] = {s0[0], s0[1], s0[2], s0[3], s1[0], s1[1], s1[2], s1[3]};
        const float sg = fq == 0 ? -1.f : 1.f;
#pragma unroll
        for (int j = 0; j < 8; ++j) v[j] = v[j] * cs[j] + sg * pr[j] * sn[j];
    }
}

struct EpiUp {
    static constexpr bool PERM = true, AFTER_DRAIN = false;
    bf16_t* H; const float* ssq; int nff; float* kp; long vpofs; float* ks; long vsofs; const float* rope;
    __device__ __forceinline__ void operator()(const f32x4 (&acc)[2][2][4][2], const Unit& u, int wr, int wc, int fr, int fq) const {
        const int row0 = u.pm * BM + wr * 64 + fr;
        if (u.pn < nff) {
#pragma unroll
            for (int ai = 0; ai < 2; ++ai)
#pragma unroll
                for (int m = 0; m < 4; ++m) { const int row = row0 + ai * HALF + m * 16; const float rs = rstd_row(ssq, row);
                    float h[8];
#pragma unroll
                    for (int n = 0; n < 2; ++n)
#pragma unroll
                        for (int i = 0; i < 4; ++i) h[4 * n + i] = silu_f(acc[ai][0][m][n][i] * rs) * (acc[ai][1][m][n][i] * rs);
                    *(u32x4*)(H + (size_t)row * FF + u.pn * 128 + wc * 32 + fq * 8) = pack8(h); }
        } else {
            const bool isk = (u.pn == nff);
#pragma unroll
            for (int ai = 0; ai < 2; ++ai)
#pragma unroll
                for (int m = 0; m < 4; ++m) { const int row = row0 + ai * HALF + m * 16; const float rs = rstd_row(ssq, row);
#pragma unroll
                    for (int bj = 0; bj < 2; ++bj) { float v[8];
#pragma unroll
                        for (int n = 0; n < 2; ++n)
#pragma unroll
                            for (int i = 0; i < 4; ++i) v[4 * n + i] = acc[ai][bj][m][n][i] * rs;
                        if (isk) rope8(v, rope, row, wc, fq);
                        const int c = bj * HALF + wc * 32 + fq * 8;
                        float* dst = nullptr;
                        if (row < MP) dst = kp + (isk ? 0 : vpofs) + (size_t)row * 256 + c; else if (row < MV) dst = ks + (isk ? 0 : vsofs) + (size_t)(row - MP) * 256 + c;
                        if (dst) { *(f32x4*)dst = (f32x4){v[0], v[1], v[2], v[3]}; *(f32x4*)(dst + 4) = (f32x4){v[4], v[5], v[6], v[7]}; } } }
        }
    }
};

struct EpiResid {
    static constexpr bool PERM = false, AFTER_DRAIN = false;
    float* X; bf16_t* XB; float* ssq_out; float scale;
    __device__ __forceinline__ void operator()(const f32x4 (&acc)[2][2][4][2], const Unit& u, int wr, int wc, int fr, int fq) const {
        const int row0 = u.pm * BM + wr * 64 + fr, col0 = u.pn * BM + wc * 32 + 4 * fq;
#pragma unroll
        for (int ai = 0; ai < 2; ++ai)
#pragma unroll
            for (int m = 0; m < 4; ++m) { const int row = row0 + ai * HALF + m * 16; float ss = 0.f;
#pragma unroll
                for (int bj = 0; bj < 2; ++bj)
#pragma unroll
                    for (int n = 0; n < 2; ++n) { const size_t off = (size_t)row * D + col0 + bj * HALF + n * 16;
                        const f32x4 xo = *(const f32x4*)(X + off); const f32x4 xn = xo + acc[ai][bj][m][n] * scale;
                        *(f32x4*)(X + off) = xn; u32x2 w; w.x = cvt_pk_bf16(xn[0], xn[1]); w.y = cvt_pk_bf16(xn[2], xn[3]); *(u32x2*)(XB + off) = w;
                        ss += (xn[0] * xn[0] + xn[1] * xn[1]) + (xn[2] * xn[2] + xn[3] * xn[3]); }
                ss += __shfl_xor(ss, 16); ss += __shfl_xor(ss, 32);
                if (fq == 0) ssq_out[(size_t)row * 16 + u.pn * 4 + wc] = ss; }
    }
};

struct EpiInA {
    static constexpr bool PERM = true, AFTER_DRAIN = false;
    bf16_t* QKV; bf16_t* GATE; bf16_t* QMEM; float* GB; const float* ssq; float* convp; float* convs; const float* a_log; const float* dt_bias;
    __device__ __forceinline__ void operator()(const f32x4 (&acc)[2][2][4][2], const Unit& u, int wr, int wc, int fr, int fq) const {
        const int row0 = u.pm * BM + wr * 64 + fr;
#pragma unroll
        for (int ai = 0; ai < 2; ++ai)
#pragma unroll
            for (int m = 0; m < 4; ++m) { const int row = row0 + ai * HALF + m * 16; const float rs = rstd_row(ssq, row);
#pragma unroll
                for (int bj = 0; bj < 2; ++bj) { float v[8];
#pragma unroll
                    for (int n = 0; n < 2; ++n)
#pragma unroll
                        for (int i = 0; i < 4; ++i) v[4 * n + i] = acc[ai][bj][m][n][i] * rs;
                    const int c = u.pn * BM + bj * HALF + wc * 32 + fq * 8;
                    if (u.pn < 9) {
                        *(u32x4*)(QKV + (size_t)row * QKVW + c) = pack8(v);
                        float* dst = nullptr;
                        if (row < MP) { const int t = row & (T - 1); if (t >= T - 3) dst = convp + (size_t)((row >> 13) * 3 + (t - (T - 3))) * QKVW + c; }
                        else if (row < MV) { const int tt = (row - MP) & 3; if (tt >= 1) dst = convs + (size_t)(((row - MP) >> 2) * 3 + tt - 1) * QKVW + c; }
                        if (dst) { *(f32x4*)dst = (f32x4){v[0], v[1], v[2], v[3]}; *(f32x4*)(dst + 4) = (f32x4){v[4], v[5], v[6], v[7]}; }
                    } else if (u.pn < 12) {
#pragma unroll
                        for (int j = 0; j < 8; ++j) v[j] = silu_f(v[j]);
                        *(u32x4*)(GATE + (size_t)row * MIXW + (c - QKVW)) = pack8(v);
                    } else if (u.pn == 12) {
                        *(u32x4*)(QMEM + (size_t)row * MEMW + (c - 3072)) = pack8(v);
                    } else if (bj == 0 && wc == 0 && fq < 3) {
#pragma unroll
                        for (int j = 0; j < 8; ++j) { const int lc = fq * 8 + j;
                            float o;
                            if (lc < 12) { const float z = v[j] + dt_bias[lc]; const float sp = z > 20.f ? z : log1pf(__expf(z)); o = -__expf(a_log[lc]) * sp; }
                            else { o = __builtin_amdgcn_rcpf(1.f + __expf(-v[j])); }
                            GB[(size_t)row * 24 + lc] = o; }
                    } } }
    }
};

struct EpiInB {
    static constexpr bool PERM = true, AFTER_DRAIN = false;
    bf16_t* QB; bf16_t* QMEM; const float* ssq; const float* rope;
    __device__ __forceinline__ void operator()(const f32x4 (&acc)[2][2][4][2], const Unit& u, int wr, int wc, int fr, int fq) const {
        const int row0 = u.pm * BM + wr * 64 + fr;
#pragma unroll
        for (int ai = 0; ai < 2; ++ai)
#pragma unroll
            for (int m = 0; m < 4; ++m) { const int row = row0 + ai * HALF + m * 16; const float rs = rstd_row(ssq, row);
#pragma unroll
                for (int bj = 0; bj < 2; ++bj) { float v[8];
#pragma unroll
                    for (int n = 0; n < 2; ++n)
#pragma unroll
                        for (int i = 0; i < 4; ++i) v[4 * n + i] = acc[ai][bj][m][n][i] * rs;
                    const int c = bj * HALF + wc * 32 + fq * 8;
                    if (u.pn < 3) { rope8(v, rope, row, wc, fq); *(u32x4*)(QB + (size_t)row * MIXW + u.pn * BM + c) = pack8(v); }
                    else *(u32x4*)(QMEM + (size_t)row * MEMW + c) = pack8(v); } }
    }
};

struct EpiMem {
    static constexpr bool PERM = false, AFTER_DRAIN = false;
    float* mk; long vofs; const float* ssqm;
    __device__ __forceinline__ void operator()(const f32x4 (&acc)[2][2][4][2], const Unit& u, int wr, int wc, int fr, int fq) const {
        const int row0 = u.pm * BM + wr * 64 + fr, col0 = wc * 32 + 4 * fq;
        float* base = mk + (long)(u.pn & 1) * vofs + (size_t)(u.pn >> 1) * 512 * 256;
#pragma unroll
        for (int ai = 0; ai < 2; ++ai)
#pragma unroll
            for (int m = 0; m < 4; ++m) { const int row = row0 + ai * HALF + m * 16; const float rs = rsqrtf(ssqm[row] * (1.f / 1024.f) + EPS);
#pragma unroll
                for (int bj = 0; bj < 2; ++bj)
#pragma unroll
                    for (int n = 0; n < 2; ++n) *(f32x4*)(base + (size_t)row * 256 + col0 + bj * HALF + n * 16) = acc[ai][bj][m][n] * rs; }
    }
};

template <class Epi, class Sched, bool ALIGN_EPI = false, bool SP2 = false>
__device__ __forceinline__ void gemm_phase(PG8_LAS unsigned char* lds, const Gemm g, const Sched& S, const Epi& E) {
    const int tid = threadIdx.x, wid = __builtin_amdgcn_readfirstlane(tid >> 6), lane = tid & 63, wr = wid >> 2, wc = wid & 3, fr = lane & 15, fq = lane >> 4;
    const int K = g.K, nt = K / BK;
    unsigned voffA[2], voffB[2];
#pragma unroll
    for (int i = 0; i < 2; ++i) { int R, C; stage_rc(tid * 16 + i * 8192, R, C); const int Rb = Epi::PERM ? ((R & ~31) + perm32(R & 31)) : R;
        voffA[i] = (unsigned)(R * K + C) * 2u; voffB[i] = (unsigned)(Rb * K + C) * 2u; }
    const size_t kstep = (size_t)(BK * 2);
    const size_t hstep = (size_t)HALF * K * 2;
    const size_t tstep = 2 * hstep;
    const unsigned ldsw = (unsigned)wid * 1024u;
    const int aoff = lds_byte(wr * 64 + fr, fq * 8), boff = lds_byte(wc * 32 + fr, fq * 8);
#define PG8_SA(b, h) (((b) * 2 + (h)) * HTB)
#define PG8_SB(b, h) ((4 + (b) * 2 + (h)) * HTB)
#define PG8_STAGE(bufoff, gbase, voff) do { _Pragma("unroll") for (int _i = 0; _i < 2; ++_i) \
        __builtin_amdgcn_global_load_lds((const unsigned*)((const char*)(gbase) + (voff)[_i]), (PG8_LAS unsigned*)(lds + (bufoff) + ldsw + _i * 8192), 16, 0, 0); } while (0)
#define PG8_LDA(dst, b, h) do { _Pragma("unroll") for (int m = 0; m < 4; ++m) _Pragma("unroll") for (int k = 0; k < 2; ++k) dst[m][k] = *(const PG8_LAS bf16x8*)(lds + PG8_SA(b, h) + aoff + m * 2048 + k * 1024); } while (0)
#define PG8_LDB(dst, b, h) do { _Pragma("unroll") for (int n = 0; n < 2; ++n) _Pragma("unroll") for (int k = 0; k < 2; ++k) dst[n][k] = *(const PG8_LAS bf16x8*)(lds + PG8_SB(b, h) + boff + n * 2048 + k * 1024); } while (0)
#define PG8_MMA(ai, bj, At, Bt) do { __builtin_amdgcn_s_setprio(1); _Pragma("unroll") for (int m = 0; m < 4; ++m) _Pragma("unroll") for (int n = 0; n < 2; ++n) _Pragma("unroll") for (int k = 0; k < 2; ++k) \
        acc[ai][bj][m][n] = __builtin_amdgcn_mfma_f32_16x16x32_bf16(Bt[n][k], At[m][k], acc[ai][bj][m][n], 0, 0, 0); __builtin_amdgcn_s_setprio(0); } while (0)
#define PG8_WAIT_V(n) asm volatile("s_waitcnt vmcnt(" #n ")" ::: "memory")
#define PG8_WAIT_L(n) asm volatile("s_waitcnt lgkmcnt(" #n ")" ::: "memory")
#define PG8_BAR __builtin_amdgcn_s_barrier()
#define PG8_SCHED __builtin_amdgcn_sched_barrier(0)
    Unit cur, nxt; int ui = 0;
    if (!S.next(0, cur)) return;
    f32x4 acc[2][2][4][2];
#pragma unroll
    for (int a = 0; a < 2; ++a)
#pragma unroll
        for (int b = 0; b < 2; ++b)
#pragma unroll
            for (int m = 0; m < 4; ++m)
#pragma unroll
                for (int n = 0; n < 2; ++n) acc[a][b][m][n] = (f32x4){0.f, 0.f, 0.f, 0.f};
    bf16x8 At[4][2], B0[2][2], B1[2][2];
    const char* cA = (const char*)g.A + (size_t)cur.pm * tstep; const char* cB = (const char*)g.Bt + (size_t)cur.pn * tstep;
    S.a_ready(cur);
    if constexpr (SP2) {
        PG8_STAGE(PG8_SB(0, 0), cB, voffB); PG8_STAGE(PG8_SB(0, 1), cB + hstep, voffB); PG8_STAGE(PG8_SA(0, 0), cA, voffA); PG8_STAGE(PG8_SA(0, 1), cA + hstep, voffA);
        if (wr == 1) PG8_BAR;
        PG8_WAIT_V(2); PG8_BAR;
        PG8_STAGE(PG8_SB(1, 0), cB + kstep, voffB); PG8_STAGE(PG8_SA(1, 0), cA + kstep, voffA); PG8_STAGE(PG8_SB(1, 1), cB + hstep + kstep, voffB);
        PG8_WAIT_V(6); PG8_BAR;
    } else {
        PG8_STAGE(PG8_SB(0, 0), cB, voffB); PG8_STAGE(PG8_SA(0, 0), cA, voffA); PG8_STAGE(PG8_SB(0, 1), cB + hstep, voffB); PG8_STAGE(PG8_SA(0, 1), cA + hstep, voffA);
        if (wr == 1) PG8_BAR;
        PG8_WAIT_V(4); PG8_BAR;
        PG8_STAGE(PG8_SB(1, 0), cB + kstep, voffB); PG8_STAGE(PG8_SA(1, 0), cA + kstep, voffA); PG8_STAGE(PG8_SB(1, 1), cB + hstep + kstep, voffB);
        PG8_WAIT_V(6); PG8_BAR;
    }
    for (;;) {
        const bool has_next = S.next(ui + 1, nxt);
        const char* nA = has_next ? (const char*)g.A + (size_t)nxt.pm * tstep : cA; const char* nB = has_next ? (const char*)g.Bt + (size_t)nxt.pn * tstep : cB;
        for (int t = 0; t < nt; t += 2) {
            const bool last = (t == nt - 2);
            const char* a1 = cA + (size_t)(t + 1) * kstep;
            const char* a2 = last ? nA : cA + (size_t)(t + 2) * kstep; const char* b2 = last ? nB : cB + (size_t)(t + 2) * kstep;
            const char* a3 = a2 + kstep; const char* b3 = b2 + kstep;
            if (last && has_next) S.a_ready(nxt);
            if constexpr (SP2) {
            PG8_LDB(B0, 0, 0); PG8_LDB(B1, 0, 1); PG8_SCHED; PG8_LDA(At, 0, 0); PG8_STAGE(PG8_SA(1, 1), a1 + hstep, voffA);
            PG8_WAIT_V(8); PG8_WAIT_L(0); PG8_BAR; PG8_MMA(0, 0, At, B0); PG8_MMA(0, 1, At, B1); PG8_BAR; PG8_SCHED;
            PG8_LDA(At, 0, 1); PG8_STAGE(PG8_SB(0, 0), b2, voffB); PG8_STAGE(PG8_SB(0, 1), b2 + hstep, voffB); PG8_STAGE(PG8_SA(0, 0), a2, voffA);
            PG8_WAIT_V(8); PG8_WAIT_L(0); PG8_BAR; PG8_MMA(1, 0, At, B0); PG8_MMA(1, 1, At, B1); PG8_BAR; PG8_SCHED;
            PG8_LDB(B0, 1, 0); PG8_LDB(B1, 1, 1); PG8_SCHED; PG8_LDA(At, 1, 0); PG8_STAGE(PG8_SA(0, 1), a2 + hstep, voffA);
            PG8_WAIT_V(8); PG8_WAIT_L(0); PG8_BAR; PG8_MMA(0, 0, At, B0); PG8_MMA(0, 1, At, B1); PG8_BAR; PG8_SCHED;
            PG8_LDA(At, 1, 1); PG8_STAGE(PG8_SB(1, 0), b3, voffB); PG8_STAGE(PG8_SB(1, 1), b3 + hstep, voffB); PG8_STAGE(PG8_SA(1, 0), a3, voffA);
            PG8_WAIT_V(8); PG8_WAIT_L(0); PG8_BAR; PG8_MMA(1, 0, At, B0); PG8_MMA(1, 1, At, B1); PG8_BAR; PG8_SCHED;
            } else {
            PG8_LDB(B0, 0, 0); PG8_SCHED; PG8_LDA(At, 0, 0); PG8_STAGE(PG8_SA(1, 1), a1 + hstep, voffA);
            PG8_WAIT_L(8); PG8_BAR; PG8_WAIT_L(0); PG8_MMA(0, 0, At, B0); PG8_BAR; PG8_SCHED;
            PG8_LDB(B1, 0, 1); PG8_STAGE(PG8_SB(0, 0), b2, voffB);
            PG8_BAR; PG8_WAIT_L(0); PG8_MMA(0, 1, At, B1); PG8_BAR;
            PG8_LDA(At, 0, 1); PG8_STAGE(PG8_SA(0, 0), a2, voffA);
            PG8_BAR; PG8_WAIT_L(0); PG8_MMA(1, 0, At, B0); PG8_BAR; PG8_SCHED;
            PG8_STAGE(PG8_SB(0, 1), b2 + hstep, voffB);
            PG8_WAIT_V(6); PG8_BAR; PG8_MMA(1, 1, At, B1); PG8_BAR;
            PG8_LDB(B0, 1, 0); PG8_SCHED; PG8_LDA(At, 1, 0); PG8_STAGE(PG8_SA(0, 1), a2 + hstep, voffA);
            PG8_WAIT_L(8); PG8_BAR; PG8_WAIT_L(0); PG8_MMA(0, 0, At, B0); PG8_BAR; PG8_SCHED;
            PG8_LDB(B1, 1, 1); PG8_STAGE(PG8_SB(1, 0), b3, voffB);
            PG8_BAR; PG8_WAIT_L(0); PG8_MMA(0, 1, At, B1); PG8_BAR;
            PG8_LDA(At, 1, 1); PG8_STAGE(PG8_SA(1, 0), a3, voffA);
            PG8_BAR; PG8_WAIT_L(0); PG8_MMA(1, 0, At, B0); PG8_BAR; PG8_SCHED;
            PG8_STAGE(PG8_SB(1, 1), b3 + hstep, voffB);
            PG8_WAIT_V(6); PG8_BAR; PG8_MMA(1, 1, At, B1); PG8_BAR;
            }
        }
        if constexpr (ALIGN_EPI) { if (wr == 0) PG8_BAR; }
        if constexpr (!Epi::AFTER_DRAIN) { E(acc, cur, wr, wc, fr, fq); S.done(cur); }
        if (!has_next) break;
#pragma unroll
        for (int a = 0; a < 2; ++a)
#pragma unroll
            for (int b = 0; b < 2; ++b)
#pragma unroll
                for (int m = 0; m < 4; ++m)
#pragma unroll
                    for (int n = 0; n < 2; ++n) acc[a][b][m][n] = (f32x4){0.f, 0.f, 0.f, 0.f};
        cur = nxt; cA = nA; cB = nB; ++ui;
        if constexpr (ALIGN_EPI) { if (wr == 1) PG8_BAR; }
    }
    PG8_WAIT_V(0);
    if constexpr (!ALIGN_EPI) { if (wr == 0) PG8_BAR; }
    PG8_BAR;
    if constexpr (Epi::AFTER_DRAIN) { E.fused(acc, cur, wr, wc, fr, fq, lds, wid, lane); S.done(cur); }
#undef PG8_SA
#undef PG8_SB
#undef PG8_STAGE
#undef PG8_LDA
#undef PG8_LDB
#undef PG8_MMA
#undef PG8_WAIT_V
#undef PG8_WAIT_L
#undef PG8_BAR
#undef PG8_SCHED
}
}

#define GAS __attribute__((address_space(1)))
#define LAS __attribute__((address_space(3)))
typedef unsigned short bf16;
typedef unsigned v4u __attribute__((ext_vector_type(4)));
typedef float f32x4 __attribute__((ext_vector_type(4)));
#define RLX_AGENT __ATOMIC_RELAXED, __HIP_MEMORY_SCOPE_AGENT
#define LDS_WAIT() asm volatile("s_waitcnt lgkmcnt(0)" ::: "memory")
__device__ __forceinline__ unsigned f2bf(float f) { unsigned u = __builtin_bit_cast(unsigned, f); return (u + 0x7fffu + ((u >> 16) & 1u)) >> 16; }
__device__ __forceinline__ unsigned pk2(float lo, float hi) { return f2bf(lo) | (f2bf(hi) << 16); }
__device__ __forceinline__ float bf2f(unsigned short u) { return __builtin_bit_cast(float, (unsigned)u << 16); }
__device__ __forceinline__ float wave_sum(float v) {
#pragma unroll
    for (int o = 32; o >= 1; o >>= 1) v += __shfl_xor(v, o);
    return v;
}
__device__ __forceinline__ float wave_max(float v) {
#pragma unroll
    for (int o = 32; o >= 1; o >>= 1) v = fmaxf(v, __shfl_xor(v, o));
    return v;
}
__device__ __forceinline__ float rdlane(float v, int l) { return __builtin_bit_cast(float, __builtin_amdgcn_readlane(__builtin_bit_cast(int, v), l)); }

#define XB_TMO      128
#define XB_XCNT(j)  (256  + 64 * (j))
#define XB_XSUB(j)  (1280 + 64 * (j))
#define XB_XGEN(j)  (2304 + 64 * (j))
#define XB_TOP      3328
#define XB_TOPGEN   3392
#define XCD_BAR_WORDS 3456
#define XB_SPIN_CAP (1u << 18)

__device__ __forceinline__ unsigned xb_ld(unsigned* p)              { return __hip_atomic_load(p, __ATOMIC_RELAXED, __HIP_MEMORY_SCOPE_AGENT); }
__device__ __forceinline__ unsigned xb_add(unsigned* p, unsigned v) { return __hip_atomic_fetch_add(p, v, __ATOMIC_RELAXED, __HIP_MEMORY_SCOPE_AGENT); }
__device__ __forceinline__ unsigned xb_xcc_id() { return (unsigned)__builtin_amdgcn_s_getreg((3 << 11) | 20) & 0xFu; }
#define XB_SPIN(cond, bar) do { unsigned _sp = 0; while (cond) { __builtin_amdgcn_s_sleep(1); \
    if ((++_sp & 255u) == 0u) { if (xb_ld(&(bar)[XB_TMO])) break; if (_sp > XB_SPIN_CAP) { atomicAdd(&(bar)[XB_TMO], 1u); break; } } } } while (0)

struct XcdBarrier {
    unsigned* bar; unsigned x;
    volatile LAS unsigned* st;
};

__device__ __forceinline__ XcdBarrier xcd_barrier_post(unsigned* bar, volatile LAS unsigned* st) {
    XcdBarrier b; b.bar = bar; b.x = xb_xcc_id(); b.st = st;
    if (threadIdx.x == 0) (void)xb_add(&bar[XB_XCNT(b.x)], 1u);
    return b;
}
__device__ __forceinline__ void xcd_barrier_complete(unsigned* bar, unsigned x, unsigned& nloc, unsigned& nx) {
    const unsigned G = gridDim.x * gridDim.y * gridDim.z;
    unsigned sum, cnt, mine, sp = 0u;
    for (;;) {
        sum = 0u; cnt = 0u; mine = 0u;
#pragma unroll
        for (unsigned j = 0; j < 16; ++j) { const unsigned c = xb_ld(&bar[XB_XCNT(j)]); sum += c; cnt += (c > 0u) ? 1u : 0u; mine = (j == x) ? c : mine; }
        if (sum == G) break;
        __builtin_amdgcn_s_sleep(1);
        if ((++sp & 255u) == 0u) { if (xb_ld(&bar[XB_TMO])) break; if (sp > XB_SPIN_CAP) { atomicAdd(&bar[XB_TMO], 1u); break; } }
    }
    nloc = mine > 0u ? mine : 1u; nx = cnt > 0u ? cnt : 1u;
}

__device__ __forceinline__ void xcd_barrier(const XcdBarrier& b) {
    asm volatile("s_waitcnt vmcnt(0)" ::: "memory");
    __syncthreads();
    if (threadIdx.x == 0) {
        unsigned* bar = b.bar;
        __builtin_amdgcn_s_waitcnt(0);
        unsigned nloc = b.st[0], nx = b.st[1];
        if (nloc == 0u) { xcd_barrier_complete(bar, b.x, nloc, nx); b.st[0] = nloc; b.st[1] = nx; }
        const unsigned old = xb_add(&bar[XB_XSUB(b.x)], 1u);
        const unsigned gen = old / nloc;
        if (old + 1u == (gen + 1u) * nloc) {
            __builtin_amdgcn_fence(__ATOMIC_RELEASE, "agent");
            asm volatile("s_waitcnt vmcnt(0)" ::: "memory");
            const unsigned og = xb_add(&bar[XB_TOP], 1u);
            const unsigned tg = og / nx;
            if (og + 1u == (tg + 1u) * nx) xb_add(&bar[XB_TOPGEN], 1u);
            else XB_SPIN(xb_ld(&bar[XB_TOPGEN]) == tg, bar);
            __builtin_amdgcn_fence(__ATOMIC_ACQUIRE, "agent");
            xb_add(&bar[XB_XGEN(b.x)], 1u);
            asm volatile("s_waitcnt vmcnt(0)" ::: "memory");
        } else {
            XB_SPIN(xb_ld(&bar[XB_XGEN(b.x)]) == gen, bar);
            __builtin_amdgcn_fence(__ATOMIC_ACQUIRE, "agent");
            asm volatile("s_waitcnt vmcnt(0)" ::: "memory");
        }
    }
    __syncthreads();
}

constexpr size_t MiB = 1u << 20;
constexpr size_t al1(size_t x) { return (x + MiB - 1) / MiB * MiB; }
constexpr size_t WS_CTL = 0, CTL_ZERO_BYTES = 1 * MiB;
constexpr size_t SZ_W13 = al1((size_t)NUPKV * D * 2), SZ_W2T = al1((size_t)D * FF * 2);
constexpr size_t WS_W13 = 1 * MiB;
constexpr size_t WS_W2T = WS_W13 + 4 * SZ_W13;
constexpr size_t WS_WINA = WS_W2T + 4 * SZ_W2T;
constexpr size_t WS_WINB = WS_WINA + al1((size_t)INA_P * D * 2);
constexpr size_t WS_WOUT = WS_WINB + 2 * MiB;
constexpr size_t WS_WMEM = WS_WOUT + 4 * MiB;
constexpr size_t WS_X = WS_WMEM + 2 * MiB;
constexpr size_t WS_XB = WS_X + al1((size_t)MT * D * 4);
constexpr size_t WS_H = WS_XB + al1((size_t)MT * D * 2);
constexpr size_t WS_QKV = WS_H + al1((size_t)MT * FF * 2);
constexpr size_t WS_GATE = WS_QKV + al1((size_t)MT * QKVW * 2);
constexpr size_t WS_QMEM = WS_GATE + al1((size_t)MT * MIXW * 2);
constexpr size_t WS_GB = WS_QMEM + al1((size_t)MT * MEMW * 2);
constexpr size_t WS_MIX = WS_GB + al1((size_t)MT * 24 * 4);
constexpr size_t WS_QB = WS_MIX + al1((size_t)MT * D * 2);
constexpr size_t WS_SSQ = WS_QB + al1((size_t)MT * MIXW * 2);
constexpr size_t WS_MEMB = WS_SSQ + al1((size_t)8 * MT * 16 * 4);
constexpr size_t WS_SSQM = WS_MEMB + 1 * MiB;
constexpr size_t WS_ROPE = WS_SSQM + 1 * MiB;
constexpr size_t WS_KBP = WS_ROPE + 1 * MiB;
constexpr size_t WS_KBS = WS_KBP + 1 * MiB;
constexpr size_t WS_CNT = WS_KBS + 2 * MiB;
constexpr size_t WS_LIST = WS_CNT + 1 * MiB;
constexpr size_t WS_PO = WS_LIST + al1((size_t)NB * NH * NBLK * T * 4);
constexpr size_t WS_ML = WS_PO + al1((size_t)MP * NH * 4 * 64 * 2);
constexpr size_t WS_REC = WS_ML + al1((size_t)MP * NH * 4 * 2 * 4);
constexpr size_t WS_EG = WS_REC + al1((size_t)3072 * 49152);
constexpr size_t WS_END = WS_EG + 1 * MiB;

constexpr size_t O_YP = 0, O_YS = O_YP + (size_t)MP * D, O_CONVP = O_YS + (size_t)MS * D, O_SP = O_CONVP + (size_t)NB * 3 * QKVW, O_KP = O_SP + (size_t)NB * NH * 4096,
                 O_VP = O_KP + (size_t)MP * 256, O_MKP = O_VP + (size_t)MP * 256, O_MVP = O_MKP + (size_t)2 * 512 * 256, O_CONVS = O_MVP + (size_t)2 * 512 * 256,
                 O_SS = O_CONVS + (size_t)SB * 3 * QKVW, O_KS = O_SS + (size_t)SB * NH * 4096, O_VS = O_KS + (size_t)MS * 256, O_END = O_VS + (size_t)MS * 256;

constexpr int RING_OFF = 0, RING_BYTES = 131072;
constexpr int LDSCTL_OFF = RING_BYTES, MISC_OFF = LDSCTL_OFF + 320;
constexpr int LDS_BYTES = 147456;
constexpr int NWAVES = 8;
constexpr int CW_BAR = 4096;

enum InIdx { I_XP = 0, I_XS, I_MEMP, I_CMK, I_CMV, I_SCONV, I_SS, I_CKK, I_CKV, I_PT, I_F1N, I_F1W1, I_F1W3, I_F1W2, I_MIXN, I_WINA, I_WINB, I_WOUT, I_CONVW, I_ALOG, I_DTB, I_ONORM,
             I_KVN, I_WKV, I_MEMN, I_WMEMKV, I_F2N, I_F2W1, I_F2W3, I_F2W2, I_FINN, N_IN };

struct Args { const void* in[N_IN]; float* out; unsigned char* ws; int ph_lo, ph_hi, mode, pad; };

struct Frame {
    LAS unsigned char* lds;
    int tid, lane, wave, G;
    const Args* a;
};

template <class RM>
__device__ __forceinline__ void p0_item(const float* W, int K, int N, const float* gain, bf16* WT, RM rm, LAS float* scr, int item, int lane) {
    const int nblk = (N + 31) / 32, kb = item / nblk, nb = item % nblk, k0 = 64 * kb, n0 = 32 * nb;
    const int nn = n0 + (lane & 31); const bool ok = nn < N;
#pragma unroll 8
    for (int i = 0; i < 32; ++i) { const int kk = 2 * i + (lane >> 5); float v = ok ? W[(size_t)(k0 + kk) * N + nn] : 0.f; if (gain) v *= gain[k0 + kk]; scr[kk * 33 + (lane & 31)] = v; }
    LDS_WAIT(); asm volatile("" ::: "memory");
    const int c = lane & 7;
#pragma unroll
    for (int j = 0; j < 4; ++j) { const int n = (lane >> 3) + 8 * j; const LAS float* s = scr + (8 * c) * 33 + n;
        v4u o; o.x = pk2(s[0 * 33], s[1 * 33]); o.y = pk2(s[2 * 33], s[3 * 33]); o.z = pk2(s[4 * 33], s[5 * 33]); o.w = pk2(s[6 * 33], s[7 * 33]);
        if (n0 + n < N) *(v4u*)(WT + (size_t)rm(n0 + n) * K + k0 + 8 * c) = o; }
    LDS_WAIT(); asm volatile("" ::: "memory");
}
struct RmOff { int off; __device__ __forceinline__ int operator()(int n) const { return off + n; } };
struct RmIl { int half; __device__ __forceinline__ int operator()(int n) const { return (n >> 7) * 256 + half * 128 + (n & 127); } };
struct RmInA { __device__ __forceinline__ int operator()(int n) const { return n < 3072 ? n : (n < 3096 ? 3328 + (n - 3072) : 3072 + (n - 3096)); } };

__device__ __forceinline__ void p0_prologue(const Frame& F) {
    const Args& A = *F.a; unsigned char* ws = A.ws;
    LAS float* scr = (LAS float*)(F.lds + RING_OFF + F.wave * 16384);
    const int gw = blockIdx.x * NWAVES + F.wave, NGW = F.G * NWAVES, lane = F.lane;
    constexpr int IT_UP = (D / 64) * (FF / 32), IT_DN = (FF / 64) * (D / 32), IT_INA = (D / 64) * ((INA + 31) / 32), IT_SQ = (D / 64) * (D / 32), IT_HALF = (D / 64) * (512 / 32);
    constexpr int NJOB = 19;
    for (int job = 0; job < NJOB; ++job) {
        int nit;
        if (job < 12) nit = (job % 3 == 2) ? IT_DN : IT_UP; else if (job == 12) nit = IT_INA; else if (job < 16) nit = IT_SQ; else nit = IT_HALF;
        for (int it = gw; it < nit; it += NGW) {
            if (job < 12) { const int lf = job / 3, l = lf >> 1, f = lf & 1, w = job % 3;
                const float* nrm = (const float*)A.in[f ? I_F2N : I_F1N] + l * D;
                bf16* w13 = (bf16*)(ws + WS_W13 + (size_t)lf * SZ_W13); bf16* w2t = (bf16*)(ws + WS_W2T + (size_t)lf * SZ_W2T);
                if (w == 0) p0_item((const float*)A.in[f ? I_F2W1 : I_F1W1] + (size_t)l * D * FF, D, FF, nrm, w13, RmIl{0}, scr, it, lane);
                else if (w == 1) p0_item((const float*)A.in[f ? I_F2W3 : I_F1W3] + (size_t)l * D * FF, D, FF, nrm, w13, RmIl{1}, scr, it, lane);
                else p0_item((const float*)A.in[f ? I_F2W2 : I_F1W2] + (size_t)l * FF * D, FF, D, nullptr, w2t, RmOff{0}, scr, it, lane);
            } else if (job == 12) p0_item((const float*)A.in[I_WINA], D, INA, (const float*)A.in[I_MIXN], (bf16*)(ws + WS_WINA), RmInA{}, scr, it, lane);
            else if (job == 13) p0_item((const float*)A.in[I_WINB], D, D, (const float*)A.in[I_MIXN] + D, (bf16*)(ws + WS_WINB), RmOff{0}, scr, it, lane);
            else if (job == 14) p0_item((const float*)A.in[I_WOUT], D, D, nullptr, (bf16*)(ws + WS_WOUT), RmOff{0}, scr, it, lane);
            else if (job == 15) p0_item((const float*)A.in[I_WOUT] + (size_t)D * D, D, D, nullptr, (bf16*)(ws + WS_WOUT) + (size_t)D * D, RmOff{0}, scr, it, lane);
            else if (job == 16) p0_item((const float*)A.in[I_WKV], D, 512, (const float*)A.in[I_KVN], (bf16*)(ws + WS_W13 + (size_t)2 * SZ_W13), RmOff{NUP}, scr, it, lane);
            else if (job == 17) p0_item((const float*)A.in[I_WMEMKV], D, 512, (const float*)A.in[I_MEMN], (bf16*)(ws + WS_WMEM), RmOff{0}, scr, it, lane);
            else p0_item((const float*)A.in[I_WMEMKV] + (size_t)D * 512, D, 512, (const float*)A.in[I_MEMN] + D, (bf16*)(ws + WS_WMEM), RmOff{512}, scr, it, lane);
        }
    }
    float* X = (float*)(ws + WS_X); bf16* XB = (bf16*)(ws + WS_XB); float* SSQ = (float*)(ws + WS_SSQ); bf16* MIX = (bf16*)(ws + WS_MIX);
    for (int m = gw; m < MT; m += NGW) {
        const float* src = m < MP ? (const float*)A.in[I_XP] + (size_t)m * D : (m < MV ? (const float*)A.in[I_XS] + (size_t)(m - MP) * D : nullptr);
        float s = 0.f;
#pragma unroll
        for (int j = 0; j < 4; ++j) { f32x4 v = src ? *((const f32x4*)src + 64 * j + lane) : (f32x4){0.f, 0.f, 0.f, 0.f};
            *((f32x4*)(X + (size_t)m * D) + 64 * j + lane) = v; s += (v[0] * v[0] + v[1] * v[1]) + (v[2] * v[2] + v[3] * v[3]);
            *((unsigned long long*)(XB + (size_t)m * D) + 64 * j + lane) = (unsigned long long)pk2(v[0], v[1]) | ((unsigned long long)pk2(v[2], v[3]) << 32);
            if (m >= MV) *((unsigned long long*)(MIX + (size_t)m * D) + 64 * j + lane) = 0ull; }
        s = wave_sum(s);
        if (lane < 16) SSQ[(size_t)m * 16 + lane] = lane == 0 ? s : 0.f;
    }
    bf16* MEMB = (bf16*)(ws + WS_MEMB); float* SSQM = (float*)(ws + WS_SSQM);
    for (int m = gw; m < 512; m += NGW) { const float* src = (const float*)A.in[I_MEMP] + (size_t)m * D; float s = 0.f;
#pragma unroll
        for (int j = 0; j < 4; ++j) { const f32x4 v = *((const f32x4*)src + 64 * j + lane); s += (v[0] * v[0] + v[1] * v[1]) + (v[2] * v[2] + v[3] * v[3]);
            *((unsigned long long*)(MEMB + (size_t)m * D) + 64 * j + lane) = (unsigned long long)pk2(v[0], v[1]) | ((unsigned long long)pk2(v[2], v[3]) << 32); }
        s = wave_sum(s); if (lane == 0) SSQM[m] = s; }
    for (int i = blockIdx.x * (NWAVES * 64) + F.tid; i < NB * NH * NBLK; i += F.G * NWAVES * 64) ((int*)(ws + WS_CNT))[i] = 0;
#if defined(NAN_PROBE)
    {
        const size_t rg[4][2] = {{WS_H, WS_MIX + (size_t)MV * D * 2}, {WS_QB, WS_SSQ}, {WS_KBP, WS_CNT}, {WS_LIST, WS_END}};
        for (int k = 0; k < 4; ++k) { v4u* p = (v4u*)(ws + rg[k][0]); const size_t nv = (rg[k][1] - rg[k][0]) / 16;
            for (size_t i = (size_t)blockIdx.x * (NWAVES * 64) + F.tid; i < nv; i += (size_t)F.G * NWAVES * 64) p[i] = (v4u){0xffffffffu, 0xffffffffu, 0xffffffffu, 0xffffffffu}; } }
#endif
    float* ROPE = (float*)(ws + WS_ROPE);
    for (int i = blockIdx.x * (NWAVES * 64) + F.tid; i < (PAST + ST) * 8; i += F.G * NWAVES * 64) { const int pos = i >> 3, k = i & 7;
        const double inv = pow(500000.0, -(double)k / 8.0), ang = (double)pos * inv; ROPE[pos * 16 + k] = (float)cos(ang); ROPE[pos * 16 + 8 + k] = (float)sin(ang); }
}

__device__ __forceinline__ void dn_scan_seq(const Frame& F, int row0, int L, int h, const float* conv0, const float* S0, float* Sout) {
    const Args& A = *F.a; unsigned char* ws = A.ws; const int lane = F.lane;
    const bf16* QKV = (const bf16*)(ws + WS_QKV); const bf16* GATE = (const bf16*)(ws + WS_GATE); const float* GB = (const float*)(ws + WS_GB); bf16* MIX = (bf16*)(ws + WS_MIX);
    const float* cw = (const float*)A.in[I_CONVW]; const int cq = h * 64 + lane;
    float wq[4], wk[4], wv[4];
#pragma unroll
    for (int j = 0; j < 4; ++j) { wq[j] = cw[j * QKVW + cq]; wk[j] = cw[j * QKVW + 768 + cq]; wv[j] = cw[j * QKVW + 1536 + cq]; }
    float q1 = 0.f, q2 = 0.f, q3 = 0.f, k1 = 0.f, k2 = 0.f, k3 = 0.f, v1 = 0.f, v2 = 0.f, v3 = 0.f;
    if (conv0) { q3 = conv0[cq]; q2 = conv0[QKVW + cq]; q1 = conv0[2 * QKVW + cq]; k3 = conv0[768 + cq]; k2 = conv0[QKVW + 768 + cq]; k1 = conv0[2 * QKVW + 768 + cq];
                 v3 = conv0[1536 + cq]; v2 = conv0[QKVW + 1536 + cq]; v1 = conv0[2 * QKVW + 1536 + cq]; }
    float S[64];
#pragma unroll
    for (int d = 0; d < 64; ++d) S[d] = S0 ? S0[d * 64 + lane] : 0.f;
    const float onorm = ((const float*)A.in[I_ONORM])[lane];
    unsigned short nq[4], nk[4], nv[4], ngt[4]; float ng[4], nb[4];
#define DN_LOAD(t0) do { _Pragma("unroll") for (int i = 0; i < 4; ++i) { const size_t r = (size_t)(row0 + (t0) + i); nq[i] = QKV[r * QKVW + cq]; nk[i] = QKV[r * QKVW + 768 + cq]; nv[i] = QKV[r * QKVW + 1536 + cq]; \
        ngt[i] = GATE[r * MIXW + cq]; ng[i] = GB[r * 24 + h]; nb[i] = GB[r * 24 + 12 + h]; } } while (0)
    DN_LOAD(0);
    for (int t = 0; t < L; t += 4) {
        unsigned short cqv[4], ckv[4], cvv[4], cgt[4]; float cg_[4], cb_[4];
#pragma unroll
        for (int i = 0; i < 4; ++i) { cqv[i] = nq[i]; ckv[i] = nk[i]; cvv[i] = nv[i]; cgt[i] = ngt[i]; cg_[i] = ng[i]; cb_[i] = nb[i]; }
        { const int tn = (t + 4 < L) ? t + 4 : t; DN_LOAD(tn); }
#pragma unroll
        for (int i = 0; i < 4; ++i) {
            const float uq = bf2f(cqv[i]), uk = bf2f(ckv[i]), uv = bf2f(cvv[i]);
            const float yq = wq[0] * q3 + wq[1] * q2 + wq[2] * q1 + wq[3] * uq, yk = wk[0] * k3 + wk[1] * k2 + wk[2] * k1 + wk[3] * uk, yv = wv[0] * v3 + wv[1] * v2 + wv[2] * v1 + wv[3] * uv;
            q3 = q2; q2 = q1; q1 = uq; k3 = k2; k2 = k1; k1 = uk; v3 = v2; v2 = v1; v1 = uv;
            const float fq = pg8::silu_f(yq), fk = pg8::silu_f(yk), fv = pg8::silu_f(yv);
            const float sq = wave_sum(fq * fq), sk = wave_sum(fk * fk);
            const float qn = fq * rsqrtf(sq + EPS) * 0.125f, kn = fk * rsqrtf(sk + EPS);
            const float a = __expf(cg_[i]), beta = cb_[i];
            float kS = 0.f;
#pragma unroll
            for (int d = 0; d < 64; ++d) kS += rdlane(kn, d) * S[d];
            float kn2 = kn; asm volatile("" : "+v"(kn2));
            const float delta = beta * (fv - a * kS);
            float o = 0.f;
#pragma unroll
            for (int d = 0; d < 64; ++d) { S[d] = a * S[d] + rdlane(kn2, d) * delta; o += rdlane(qn, d) * S[d]; }
            const float ms = wave_sum(o * o) * (1.f / 64.f);
            const float ov = o * rsqrtf(ms + EPS) * onorm * bf2f(cgt[i]);
            MIX[(size_t)(row0 + t + i) * D + cq] = (bf16)f2bf(ov);
            __builtin_amdgcn_sched_barrier(0);
        }
    }
#undef DN_LOAD
#pragma unroll
    for (int d = 0; d < 64; ++d) Sout[d * 64 + lane] = S[d];
}

__device__ __forceinline__ void attn_seg(const float (&q)[64], const float* Kp, const float* Vp, int stride, int nk, float& m, float& l, float& o, int lane) {
    float s[4];
#pragma unroll
    for (int i = 0; i < 4; ++i) { const int key = i * 64 + lane; float a = -INFINITY;
        if (key < nk) { const f32x4* kr = (const f32x4*)(Kp + (size_t)key * stride); a = 0.f;
#pragma unroll
            for (int j = 0; j < 16; ++j) { const f32x4 kv = kr[j]; a += (q[4 * j] * kv[0] + q[4 * j + 1] * kv[1]) + (q[4 * j + 2] * kv[2] + q[4 * j + 3] * kv[3]); } }
        s[i] = a; }
    const float mx = wave_max(fmaxf(fmaxf(s[0], s[1]), fmaxf(s[2], s[3])));
    const float mn = fmaxf(m, mx), corr = __expf(m - mn);
    float p[4], ps = 0.f;
#pragma unroll
    for (int i = 0; i < 4; ++i) { p[i] = (s[i] == -INFINITY) ? 0.f : __expf(s[i] - mn); ps += p[i]; }
    l = l * corr + wave_sum(ps); o *= corr; m = mn;
#pragma unroll
    for (int i = 0; i < 4; ++i) {
        if (i * 64 < nk) {
            for (int j0 = 0; j0 < 64 && i * 64 + j0 < nk; j0 += 16) { float vv[16];
#pragma unroll
                for (int u = 0; u < 16; ++u) { int key = i * 64 + j0 + u; key = key < nk ? key : nk - 1; vv[u] = Vp[(size_t)key * stride + lane]; }
#pragma unroll
                for (int u = 0; u < 16; ++u) o += rdlane(p[i], j0 + u) * vv[u]; } } }
}

__device__ __forceinline__ void moba_task(const Frame& F, int row, int h) {
    const Args& A = *F.a; unsigned char* ws = A.ws; const int lane = F.lane, g = h / 3;
    const bf16* QB = (const bf16*)(ws + WS_QB); bf16* MIX = (bf16*)(ws + WS_MIX);
    const float qv = bf2f(QB[(size_t)row * MIXW + h * 64 + lane]) * 0.125f;
    float q[64];
#pragma unroll
    for (int d = 0; d < 64; ++d) q[d] = rdlane(qv, d);
    float m = -INFINITY, l = 0.f, o = 0.f;
    const bool prompt = row < MP;
    const int b = prompt ? (row >> 13) : ((row - MP) >> 2), t = prompt ? (row & (T - 1)) : ((row - MP) & 3), qb = prompt ? (t >> 8) : NBLK;
    const float* kbar = prompt ? (const float*)(ws + WS_KBP) : (const float*)(ws + WS_KBS);
    float val = -INFINITY;
    if (lane < qb) { const f32x4* kr = (const f32x4*)(kbar + (size_t)((b * NBLK + lane) * NKV + g) * 64); float a = 0.f;
#pragma unroll
        for (int j = 0; j < 16; ++j) { const f32x4 kv = kr[j]; a += (q[4 * j] * kv[0] + q[4 * j + 1] * kv[1]) + (q[4 * j + 2] * kv[2] + q[4 * j + 3] * kv[3]); }
        val = a; }
    const float* KP = A.out + O_KP; const float* VP = A.out + O_VP; const float* KS = A.out + O_KS; const float* VS = A.out + O_VS;
    const float* CK = (const float*)A.in[I_CKK]; const float* CV = (const float*)A.in[I_CKV]; const int* PT = (const int*)A.in[I_PT];
    for (int r = 0; r < 3; ++r) {
        const float mx = wave_max(val);
        if (mx == -INFINITY) break;
        const unsigned long long bal = __ballot(val == mx); const int sel = __ffsll((long long)bal) - 1;
        if (lane == sel) val = -INFINITY;
        if (prompt) { const size_t off = (size_t)(b * T + sel * BLK) * 256 + g * 64; attn_seg(q, KP + off, VP + off, 256, BLK, m, l, o, lane); }
        else {
#pragma unroll 1
            for (int hf = 0; hf < 2; ++hf) { const int pg = PT[b * NPAGES + 2 * sel + hf]; const size_t off = ((size_t)pg * PAGE * NKV + g) * 64; attn_seg(q, CK + off, CV + off, 256, PAGE, m, l, o, lane); } }
    }
    if (prompt) { const size_t off = (size_t)(b * T + qb * BLK) * 256 + g * 64; attn_seg(q, KP + off, VP + off, 256, (t & (BLK - 1)) + 1, m, l, o, lane); }
    else { const size_t off = (size_t)(b * ST) * 256 + g * 64; attn_seg(q, KS + off, VS + off, 256, t + 1, m, l, o, lane); }
    MIX[(size_t)row * D + h * 64 + lane] = (bf16)f2bf(o / l);
}
__device__ __forceinline__ void mem_task(const Frame& F, int row, int j, int lyr) {
    const Args& A = *F.a; unsigned char* ws = A.ws; const int lane = F.lane;
    const bf16* QM = (const bf16*)(ws + WS_QMEM); bf16* MIX = (bf16*)(ws + WS_MIX);
    const float qv = bf2f(QM[(size_t)row * MEMW + j * 64 + lane]) * 0.125f;
    float q[64];
#pragma unroll
    for (int d = 0; d < 64; ++d) q[d] = rdlane(qv, d);
    float m = -INFINITY, l = 0.f, o = 0.f;
    const float *Kp, *Vp;
    if (row < MP) { const size_t off = (size_t)((lyr * 2 + (row >> 13)) * NMEM) * 256 + j * 64; Kp = A.out + O_MKP + off; Vp = A.out + O_MVP + off; }
    else { const size_t off = (size_t)((lyr * SB + ((row - MP) >> 2)) * NMEM) * 256 + j * 64; Kp = (const float*)A.in[I_CMK] + off; Vp = (const float*)A.in[I_CMV] + off; }
    attn_seg(q, Kp, Vp, 256, NMEM, m, l, o, lane);
    MIX[(size_t)row * D + MIXW + j * 64 + lane] = (bf16)f2bf(o / l);
}
__device__ __forceinline__ void kbar_task(const Frame& F, bool prompt, int b, int n, int g) {
    const Args& A = *F.a; const int lane = F.lane; float s = 0.f;
    if (prompt) { const float* kp = A.out + O_KP + (size_t)(b * T + n * BLK) * 256 + g * 64 + lane;
#pragma unroll 8
        for (int j = 0; j < BLK; ++j) s += kp[(size_t)j * 256];
        ((float*)(A.ws + WS_KBP))[(size_t)((b * NBLK + n) * NKV + g) * 64 + lane] = s * (1.f / BLK);
    } else { const int* PT = (const int*)A.in[I_PT];
#pragma unroll 1
        for (int hf = 0; hf < 2; ++hf) { const float* kp = (const float*)A.in[I_CKK] + ((size_t)PT[b * NPAGES + 2 * n + hf] * PAGE * NKV + g) * 64 + lane;
#pragma unroll 8
            for (int j = 0; j < PAGE; ++j) s += kp[(size_t)j * 256]; }
        ((float*)(A.ws + WS_KBS))[(size_t)((b * NBLK + n) * NKV + g) * 64 + lane] = s * (1.f / BLK);
    }
}

__device__ __forceinline__ void kbar_s_task(const Frame& F, int b, int n) {
    const Args& A = *F.a; const int lane = F.lane; const int* PT = (const int*)A.in[I_PT]; f32x4 s = {0.f, 0.f, 0.f, 0.f};
#pragma unroll 1
    for (int hf = 0; hf < 2; ++hf) { const f32x4* kp = (const f32x4*)((const float*)A.in[I_CKK] + (size_t)PT[b * NPAGES + 2 * n + hf] * PAGE * 256) + lane;
#pragma unroll 16
        for (int j = 0; j < PAGE; ++j) s += kp[(size_t)j * 64]; }
    *((f32x4*)((float*)(A.ws + WS_KBS) + (size_t)(b * NBLK + n) * 256) + lane) = s * (1.f / BLK);
}

typedef short bf16x8 __attribute__((ext_vector_type(8)));
typedef float f32x16 __attribute__((ext_vector_type(16)));
typedef unsigned u32x2v __attribute__((ext_vector_type(2)));
constexpr int KIMG_ROW = 144, KIMG_BYTES = 256 * KIMG_ROW;
constexpr int VIMG_ROW = 528, VIMG_BYTES = 64 * VIMG_ROW;
constexpr int AT_K = 0, AT_V = KIMG_BYTES, AT_SCHED = 73728;
__device__ __forceinline__ int crow(int i, int h) { return (i & 3) + 8 * (i >> 2) + 4 * h; }
__device__ __forceinline__ unsigned cvtpk(float lo, float hi) { typedef float f2_t __attribute__((ext_vector_type(2))); typedef __bf16 b2_t __attribute__((ext_vector_type(2)));
    f2_t v = {lo, hi}; b2_t b = __builtin_convertvector(v, b2_t); return __builtin_bit_cast(unsigned, b); }

__device__ __forceinline__ void fill_kv(LAS unsigned char* lds, const float* Kp, const float* Vp, int stride, int tid) {
    const int key = tid >> 1, half = tid & 1;
    const f32x4* kr = (const f32x4*)(Kp + (size_t)key * stride + 32 * half); const f32x4* vr = (const f32x4*)(Vp + (size_t)key * stride + 32 * half);
    f32x4 kv[8], vv[8];
#pragma unroll
    for (int j = 0; j < 8; ++j) { kv[j] = kr[j]; vv[j] = vr[j]; }
#pragma unroll
    for (int j = 0; j < 4; ++j) { v4u w; w.x = cvtpk(kv[2 * j][0], kv[2 * j][1]); w.y = cvtpk(kv[2 * j][2], kv[2 * j][3]); w.z = cvtpk(kv[2 * j + 1][0], kv[2 * j + 1][1]); w.w = cvtpk(kv[2 * j + 1][2], kv[2 * j + 1][3]);
        *(LAS v4u*)(lds + AT_K + key * KIMG_ROW + half * 64 + j * 16) = w; }
#pragma unroll
    for (int j = 0; j < 8; ++j)
#pragma unroll
        for (int i = 0; i < 4; ++i) *(LAS unsigned short*)(lds + AT_V + (32 * half + 4 * j + i) * VIMG_ROW + key * 2) = (unsigned short)f2bf(vv[j][i]);
}

__device__ __forceinline__ void attn_tile32(LAS const unsigned char* lds, const bf16* qptr, bool causal, int qloc, bf16* dst, float& ms_out, float& ls_out, int lane) {
    const int r = lane & 31, h = lane >> 5;
    bf16x8 qf[4];
#pragma unroll
    for (int kk = 0; kk < 4; ++kk) qf[kk] = *(const bf16x8*)(qptr + 16 * kk + 8 * h);
    f32x16 acc[8];
#pragma unroll
    for (int kt = 0; kt < 8; ++kt) {
#pragma unroll
        for (int i = 0; i < 16; ++i) acc[kt][i] = 0.f;
#pragma unroll
        for (int kk = 0; kk < 4; ++kk) { const bf16x8 kf = *(LAS const bf16x8*)(lds + AT_K + (32 * kt + r) * KIMG_ROW + (16 * kk + 8 * h) * 2);
            acc[kt] = __builtin_amdgcn_mfma_f32_32x32x16_bf16(kf, qf[kk], acc[kt], 0, 0, 0); }
    }
    if (causal) {
#pragma unroll
        for (int kt = 0; kt < 8; ++kt)
#pragma unroll
            for (int i = 0; i < 16; ++i) if (32 * kt + crow(i, h) > qloc) acc[kt][i] = -INFINITY;
    }
    float mx = -INFINITY;
#pragma unroll
    for (int kt = 0; kt < 8; ++kt)
#pragma unroll
        for (int i = 0; i < 16; ++i) mx = fmaxf(mx, acc[kt][i]);
    mx = fmaxf(mx, __shfl_xor(mx, 32));
    const float c = 0.125f * 1.4426950408889634f, ms = mx * c;
    float ls = 0.f;
#pragma unroll
    for (int kt = 0; kt < 8; ++kt)
#pragma unroll
        for (int i = 0; i < 16; ++i) { const float p = exp2f(acc[kt][i] * c - ms); acc[kt][i] = p; ls += p; }
    ls += __shfl_xor(ls, 32);
    f32x16 O[2];
#pragma unroll
    for (int i = 0; i < 16; ++i) { O[0][i] = 0.f; O[1][i] = 0.f; }
#pragma unroll
    for (int kt = 0; kt < 8; ++kt)
#pragma unroll
        for (int s = 0; s < 2; ++s) {
            v4u pw; pw.x = cvtpk(acc[kt][8 * s + 0], acc[kt][8 * s + 1]); pw.y = cvtpk(acc[kt][8 * s + 2], acc[kt][8 * s + 3]); pw.z = cvtpk(acc[kt][8 * s + 4], acc[kt][8 * s + 5]); pw.w = cvtpk(acc[kt][8 * s + 6], acc[kt][8 * s + 7]);
            const bf16x8 pf = __builtin_bit_cast(bf16x8, pw);
#pragma unroll
            for (int dt = 0; dt < 2; ++dt) { LAS const unsigned char* vp = lds + AT_V + (32 * dt + r) * VIMG_ROW + (32 * kt + 16 * s + 4 * h) * 2;
                const u32x2v lo = *(LAS const u32x2v*)vp, hi = *(LAS const u32x2v*)(vp + 16);
                v4u vw; vw.x = lo.x; vw.y = lo.y; vw.z = hi.x; vw.w = hi.y;
                O[dt] = __builtin_amdgcn_mfma_f32_32x32x16_bf16(pf, __builtin_bit_cast(bf16x8, vw), O[dt], 0, 0, 0); }
        }
    const float linv = 1.f / ls; const unsigned long long dp = (unsigned long long)dst;
#pragma unroll
    for (int i = 0; i < 16; ++i) { const int ql = crow(i, h);
        const float li = __shfl(linv, ql); const unsigned dlo = __shfl((unsigned)dp, ql), dhi = __shfl((unsigned)(dp >> 32), ql);
        bf16* dq = (bf16*)(((unsigned long long)dhi << 32) | dlo);
        if (dq) { dq[r] = (bf16)f2bf(O[0][i] * li); dq[32 + r] = (bf16)f2bf(O[1][i] * li); } }
    ms_out = ms; ls_out = ls;
}

__device__ __forceinline__ void gate_task(const Frame& F, int b, int h, int t0) {
    const Args& A = *F.a; unsigned char* ws = A.ws; const int lane = F.lane, g = h / 3, t = t0 + lane, qb = t0 >> 8, row = b * T + t;
    const bf16* QB = (const bf16*)(ws + WS_QB); const float* kbar = (const float*)(ws + WS_KBP) + (size_t)(b * NBLK) * NKV * 64 + g * 64;
    int* CNT = (int*)(ws + WS_CNT) + (b * NH + h) * NBLK; int* LIST = (int*)(ws + WS_LIST) + (size_t)(b * NH + h) * NBLK * T; float* ML = (float*)(ws + WS_ML) + (size_t)(row * NH + h) * 8;
    float q[64];
    { const v4u* qp = (const v4u*)(QB + (size_t)row * MIXW + h * 64);
#pragma unroll
      for (int j = 0; j < 8; ++j) { const v4u w = qp[j]; q[8 * j] = bf2f(w.x & 0xffff); q[8 * j + 1] = bf2f(w.x >> 16); q[8 * j + 2] = bf2f(w.y & 0xffff); q[8 * j + 3] = bf2f(w.y >> 16);
          q[8 * j + 4] = bf2f(w.z & 0xffff); q[8 * j + 5] = bf2f(w.z >> 16); q[8 * j + 6] = bf2f(w.w & 0xffff); q[8 * j + 7] = bf2f(w.w >> 16); } }
    float v0 = -INFINITY, v1 = -INFINITY, v2 = -INFINITY; int i0 = -1, i1 = -1, i2 = -1;
    for (int n = 0; n < qb; ++n) { const f32x4* kr = (const f32x4*)(kbar + (size_t)n * NKV * 64); float a = 0.f;
#pragma unroll
        for (int j = 0; j < 16; ++j) { const f32x4 kv = kr[j]; a += (q[4 * j] * kv[0] + q[4 * j + 1] * kv[1]) + (q[4 * j + 2] * kv[2] + q[4 * j + 3] * kv[3]); }
        const bool g0 = a > v0, g1 = a > v1, g2 = a > v2;
        v2 = g1 ? v1 : (g2 ? a : v2); i2 = g1 ? i1 : (g2 ? n : i2);
        v1 = g0 ? v0 : (g1 ? a : v1); i1 = g0 ? i0 : (g1 ? n : i1);
        v0 = g0 ? a : v0; i0 = g0 ? n : i0; }
    for (int n = 0; n < qb; ++n) { const bool mt = (i0 == n) | (i1 == n) | (i2 == n); const unsigned long long mask = __ballot(mt);
        if (mask) { const int first = __ffsll((long long)mask) - 1; int base = 0;
            if (lane == first) base = __hip_atomic_fetch_add(CNT + n, (int)__popcll(mask), __ATOMIC_RELAXED, __HIP_MEMORY_SCOPE_AGENT);
            base = __shfl(base, first);
            if (mt) { const int pos = base + (int)__popcll(mask & ((1ull << lane) - 1ull)); const int rk = (i0 == n) ? 0 : ((i1 == n) ? 1 : 2); LIST[(size_t)n * T + pos] = t | (rk << 16); } } }
    if (qb < 3) { if (i0 < 0) { ML[0] = -INFINITY; ML[1] = 0.f; } if (i1 < 0) { ML[2] = -INFINITY; ML[3] = 0.f; } if (i2 < 0) { ML[4] = -INFINITY; ML[5] = 0.f; } }
}

__device__ __forceinline__ void attn_units(const Frame& F, bool with_moba, int lyr, int w, int GW) {
    const Args& A = *F.a; unsigned char* ws = A.ws; const int tid = F.tid, lane = F.lane, wave = F.wave;
    LAS int* P = (LAS int*)(F.lds + AT_SCHED);
    const int* CNT = (const int*)(ws + WS_CNT);
    if (tid < 264) { int nt;
        if (tid < 256) { nt = 0; if (with_moba) { const int b = tid >> 7, g = (tid >> 5) & 3, n = tid & 31; nt = 24;
#pragma unroll
                for (int hl = 0; hl < 3; ++hl) nt += (CNT[(b * NH + 3 * g + hl) * NBLK + n] + 31) >> 5; } }
        else nt = 256;
        P[265 + tid] = nt; }
    __syncthreads();
    if (tid == 0) { int s = 0; for (int u = 0; u < 264; ++u) { P[u] = s; s += P[265 + u]; } P[264] = s; }
    __syncthreads();
    const int Ttot = P[264]; const int lo = (int)((long long)Ttot * w / GW), hi = (int)((long long)Ttot * (w + 1) / GW);
    int u = 0; while (u < 263 && P[u + 1] <= lo) ++u;
    const bf16* QB = (const bf16*)(ws + WS_QB); const bf16* QM = (const bf16*)(ws + WS_QMEM); bf16* MIX = (bf16*)(ws + WS_MIX);
    bf16* PO = (bf16*)(ws + WS_PO); float* ML = (float*)(ws + WS_ML); const int* LIST = (const int*)(ws + WS_LIST);
    for (; u < 264 && P[u] < hi; ++u) {
        const int pu = P[u], ta = (lo > pu ? lo : pu) - pu, tb = (hi < P[u + 1] ? hi : P[u + 1]) - pu;
        if (ta >= tb) continue;
        const bool moba = u < 256; int b, g, n = 0; const float *Kp, *Vp;
        if (moba) { b = u >> 7; g = (u >> 5) & 3; n = u & 31; const size_t off = (size_t)(b * T + n * BLK) * 256 + g * 64; Kp = A.out + O_KP + off; Vp = A.out + O_VP + off; }
        else { b = (u - 256) >> 2; g = (u - 256) & 3; const size_t off = (size_t)((lyr * 2 + b) * NMEM) * 256 + g * 64; Kp = A.out + O_MKP + off; Vp = A.out + O_MVP + off; }
        __syncthreads();
        fill_kv(F.lds, Kp, Vp, 256, tid);
        __syncthreads();
        int c0 = 0, c1 = 0;
        if (moba) { c0 = (CNT[(b * NH + 3 * g) * NBLK + n] + 31) >> 5; c1 = (CNT[(b * NH + 3 * g + 1) * NBLK + n] + 31) >> 5; }
        for (int tau = ta + wave; tau < tb; tau += NWAVES) {
            const int r = lane & 31; const bf16* qptr; bf16* dst = nullptr; bool causal = false; int qloc = 0; float* mlp = nullptr;
            if (moba) {
                int hl, tq, rk; bool valid = true;
                if (tau < 24) { hl = tau >> 3; tq = n * BLK + (tau & 7) * 32 + r; rk = 3; causal = true; qloc = (tau & 7) * 32 + r; }
                else { int ti = tau - 24; hl = 0; if (ti >= c0) { ti -= c0; hl = 1; if (ti >= c1) { ti -= c1; hl = 2; } }
                    const int hd = 3 * g + hl, cnt = CNT[(b * NH + hd) * NBLK + n], pos = ti * 32 + r; valid = pos < cnt;
                    const int e = LIST[(size_t)((b * NH + hd) * NBLK + n) * T + (valid ? pos : 0)]; tq = e & 0xffff; rk = e >> 16; }
                const int hd = 3 * g + hl, row = b * T + tq; qptr = QB + (size_t)row * MIXW + hd * 64;
                if (valid) { const size_t p = ((size_t)row * NH + hd) * 4 + rk; dst = PO + p * 64; mlp = ML + p * 2; }
            } else { const int row = b * T + tau * 32 + r; qptr = QM + (size_t)row * MEMW + g * 64; dst = MIX + (size_t)row * D + MIXW + g * 64; }
            float ms, ls;
            attn_tile32(F.lds, qptr, causal, qloc, dst, ms, ls, lane);
            if (mlp && lane < 32) { mlp[0] = ms; mlp[1] = ls; }
        }
    }
    __syncthreads();
}

__device__ __forceinline__ void combine_partials(const Frame& F) {
    const Args& A = *F.a; unsigned char* ws = A.ws;
    const bf16* PO = (const bf16*)(ws + WS_PO); const float* ML = (const float*)(ws + WS_ML); bf16* MIX = (bf16*)(ws + WS_MIX);
    const int nthr = F.G * NWAVES * 64;
    for (int it = blockIdx.x * (NWAVES * 64) + F.tid; it < MP * NH * 8; it += nthr) {
        const int p = it >> 3, c = it & 7, row = p / NH, hd = p % NH;
        const f32x4 ml0 = *(const f32x4*)(ML + (size_t)p * 8), ml1 = *(const f32x4*)(ML + (size_t)p * 8 + 4);
        const float m[4] = {ml0[0], ml0[2], ml1[0], ml1[2]}, l[4] = {ml0[1], ml0[3], ml1[1], ml1[3]};
        const float M = fmaxf(fmaxf(m[0], m[1]), fmaxf(m[2], m[3]));
        float wgt[4], ws_ = 0.f;
#pragma unroll
        for (int s = 0; s < 4; ++s) { wgt[s] = l[s] > 0.f ? exp2f(m[s] - M) * l[s] : 0.f; ws_ += wgt[s]; }
        float o[8];
#pragma unroll
        for (int j = 0; j < 8; ++j) o[j] = 0.f;
#pragma unroll
        for (int s = 0; s < 4; ++s) { if (wgt[s] > 0.f) { const v4u v = *(const v4u*)(PO + ((size_t)p * 4 + s) * 64 + c * 8);
            o[0] += wgt[s] * bf2f(v.x & 0xffff); o[1] += wgt[s] * bf2f(v.x >> 16); o[2] += wgt[s] * bf2f(v.y & 0xffff); o[3] += wgt[s] * bf2f(v.y >> 16);
            o[4] += wgt[s] * bf2f(v.z & 0xffff); o[5] += wgt[s] * bf2f(v.z >> 16); o[6] += wgt[s] * bf2f(v.w & 0xffff); o[7] += wgt[s] * bf2f(v.w >> 16); } }
        const float inv = 1.f / ws_;
        v4u ov; ov.x = pk2(o[0] * inv, o[1] * inv); ov.y = pk2(o[2] * inv, o[3] * inv); ov.z = pk2(o[4] * inv, o[5] * inv); ov.w = pk2(o[6] * inv, o[7] * inv);
        *(v4u*)(MIX + (size_t)row * D + hd * 64 + c * 8) = ov;
    }
}

constexpr int REC_WM = 0, REC_QG = 8192, REC_AI = 16384, REC_KDT = 24576, REC_U = 32768, REC_BYTES = 49152;
constexpr int NCH = T / 64, NCHUNKS = NB * NH * NCH;
__device__ __forceinline__ int kinv(int x) { return ((x & 12) << 1) | ((x >> 4) << 2) | (x & 3); }
__device__ __forceinline__ int kfwd(int p) { const int q4 = p >> 3, j = p & 7; return j < 4 ? 4 * q4 + j : 16 + 4 * q4 + (j - 4); }
#define BAR_SYNC() do { asm volatile("s_waitcnt lgkmcnt(0)" ::: "memory"); __builtin_amdgcn_s_barrier(); asm volatile("" ::: "memory"); } while (0)
#define BAR_SYNC_VM() do { asm volatile("s_waitcnt vmcnt(0) lgkmcnt(0)" ::: "memory"); __builtin_amdgcn_s_barrier(); asm volatile("" ::: "memory"); } while (0)

constexpr int DA_HALF = 65536, DA_KH = 0, DA_KL = 9216, DA_QH = 18432, DA_MM = 0  , DA_VF = 27648, DA_KF = 44288, DA_G = 60928  ;

__device__ __forceinline__ void dn_a_pair(const Frame& F, int pair) {
    const Args& A = *F.a; unsigned char* ws = A.ws; const int tid = F.tid, lane = F.lane, wave = F.wave;
    const int hw = wave >> 2, wl = wave & 3, t4 = tid & 255;
    const int id = 2 * pair + hw, bh = id / NCH, n = id % NCH, b = bh / NH, h = bh % NH, row0 = b * T + n * 64;
    LAS unsigned char* L = F.lds + hw * DA_HALF;
    const bf16* QKV = (const bf16*)(ws + WS_QKV); const float* GB = (const float*)(ws + WS_GB);
    unsigned char* rec = ws + WS_REC + (size_t)id * REC_BYTES;
    LAS float* GC = (LAS float*)(L + DA_G); LAS float* BT = GC + 64;
    if (wl == 0) { float g = GB[(size_t)(row0 + lane) * 24 + h]; const float be = GB[(size_t)(row0 + lane) * 24 + 12 + h];
#pragma unroll
        for (int o = 1; o < 64; o <<= 1) { const float up = __shfl_up(g, o); if (lane >= o) g += up; }
        GC[lane] = g; BT[lane] = be;
        if (lane == 63) ((float*)(ws + WS_EG))[id] = __expf(g); }
    BAR_SYNC();
    {   const int c = t4 >> 2, part = t4 & 3, ch0 = h * 64 + 16 * part; const float* cw = (const float*)A.in[I_CONVW];
        float qv[16], kv[16], vv[16];
#pragma unroll
        for (int mtx = 0; mtx < 3; ++mtx) { float y[16];
#pragma unroll
            for (int i = 0; i < 16; ++i) y[i] = 0.f;
#pragma unroll
            for (int j = 0; j < 4; ++j) {
                const int tt = n * 64 + c - 3 + j;
                v4u r0 = {0u, 0u, 0u, 0u}, r1 = {0u, 0u, 0u, 0u};
                if (tt >= 0) { const v4u* p = (const v4u*)(QKV + (size_t)(b * T + tt) * QKVW + mtx * MIXW + ch0); r0 = p[0]; r1 = p[1]; }
                const f32x4* wp = (const f32x4*)(cw + (size_t)j * QKVW + mtx * MIXW + ch0); const f32x4 w0 = wp[0], w1 = wp[1], w2 = wp[2], w3 = wp[3];
                y[0] += w0[0] * bf2f(r0.x & 0xffff); y[1] += w0[1] * bf2f(r0.x >> 16); y[2] += w0[2] * bf2f(r0.y & 0xffff); y[3] += w0[3] * bf2f(r0.y >> 16);
                y[4] += w1[0] * bf2f(r0.z & 0xffff); y[5] += w1[1] * bf2f(r0.z >> 16); y[6] += w1[2] * bf2f(r0.w & 0xffff); y[7] += w1[3] * bf2f(r0.w >> 16);
                y[8] += w2[0] * bf2f(r1.x & 0xffff); y[9] += w2[1] * bf2f(r1.x >> 16); y[10] += w2[2] * bf2f(r1.y & 0xffff); y[11] += w2[3] * bf2f(r1.y >> 16);
                y[12] += w3[0] * bf2f(r1.z & 0xffff); y[13] += w3[1] * bf2f(r1.z >> 16); y[14] += w3[2] * bf2f(r1.w & 0xffff); y[15] += w3[3] * bf2f(r1.w >> 16); }
            float ss = 0.f;
#pragma unroll
            for (int i = 0; i < 16; ++i) { y[i] = pg8::silu_f(y[i]); ss += y[i] * y[i]; }
            if (mtx < 2) { ss += __shfl_xor(ss, 1); ss += __shfl_xor(ss, 2); const float rn = rsqrtf(ss + EPS);
#pragma unroll
                for (int i = 0; i < 16; ++i) y[i] *= rn; }
#pragma unroll
            for (int i = 0; i < 16; ++i) { if (mtx == 0) qv[i] = y[i]; else if (mtx == 1) kv[i] = y[i]; else vv[i] = y[i]; }
        }
        {   unsigned kh[8], kl[8], qh[8];
#pragma unroll
            for (int i = 0; i < 8; ++i) { const unsigned h0 = f2bf(kv[2 * i]), h1 = f2bf(kv[2 * i + 1]); kh[i] = h0 | (h1 << 16);
                kl[i] = pk2(kv[2 * i] - bf2f((unsigned short)h0), kv[2 * i + 1] - bf2f((unsigned short)h1)); qh[i] = pk2(qv[2 * i], qv[2 * i + 1]); }
            LAS unsigned char* rowp = L + c * 144 + part * 32;
            *(LAS v4u*)(rowp + DA_KH) = (v4u){kh[0], kh[1], kh[2], kh[3]}; *(LAS v4u*)(rowp + DA_KH + 16) = (v4u){kh[4], kh[5], kh[6], kh[7]};
            *(LAS v4u*)(rowp + DA_KL) = (v4u){kl[0], kl[1], kl[2], kl[3]}; *(LAS v4u*)(rowp + DA_KL + 16) = (v4u){kl[4], kl[5], kl[6], kl[7]};
            *(LAS v4u*)(rowp + DA_QH) = (v4u){qh[0], qh[1], qh[2], qh[3]}; *(LAS v4u*)(rowp + DA_QH + 16) = (v4u){qh[4], qh[5], qh[6], qh[7]};
            LAS float* vf = (LAS float*)(L + DA_VF) + c * 65 + 16 * part; LAS float* kf = (LAS float*)(L + DA_KF) + c * 65 + 16 * part;
#pragma unroll
            for (int i = 0; i < 16; ++i) { vf[i] = vv[i]; kf[i] = kv[i]; } }
        {   const float sc = 0.125f * __expf(GC[c]); bf16* qg = (bf16*)(rec + REC_QG) + c * 64 + 32 * (part >> 1) + 4 * (part & 1);
#pragma unroll
            for (int gq = 0; gq < 4; ++gq) { u32x2v w; w.x = pk2(qv[4 * gq] * sc, qv[4 * gq + 1] * sc); w.y = pk2(qv[4 * gq + 2] * sc, qv[4 * gq + 3] * sc); *(u32x2v*)(qg + 8 * gq) = w; } }
    }
    BAR_SYNC();
    f32x16 mreg;
    const int r = lane & 31, hh = lane >> 5;
    if (wl < 3) { const int ti = wl == 0 ? 0 : 1, tj = wl == 2 ? 1 : 0;
        f32x16 acc;
#pragma unroll
        for (int i = 0; i < 16; ++i) acc[i] = 0.f;
#pragma unroll
        for (int kk = 0; kk < 4; ++kk) { const int ao = (32 * ti + r) * 144 + (16 * kk + 8 * hh) * 2, bo = (32 * tj + r) * 144 + (16 * kk + 8 * hh) * 2;
            const bf16x8 ah = *(LAS const bf16x8*)(L + DA_KH + ao), al = *(LAS const bf16x8*)(L + DA_KL + ao), bh_ = *(LAS const bf16x8*)(L + DA_KH + bo), bl = *(LAS const bf16x8*)(L + DA_KL + bo);
            acc = __builtin_amdgcn_mfma_f32_32x32x16_bf16(ah, bh_, acc, 0, 0, 0); acc = __builtin_amdgcn_mfma_f32_32x32x16_bf16(ah, bl, acc, 0, 0, 0); acc = __builtin_amdgcn_mfma_f32_32x32x16_bf16(al, bh_, acc, 0, 0, 0); }
        const int s = 32 * tj + r; const float gs = GC[s];
#pragma unroll
        for (int i = 0; i < 16; ++i) { const int c = 32 * ti + crow(i, hh); mreg[i] = (s < c) ? BT[c] * acc[i] * __expf(GC[c] - gs) : 0.f; }
    } else {
        bf16* ai = (bf16*)(rec + REC_AI);
#pragma unroll
        for (int tile = 0; tile < 3; ++tile) { const int ti = tile == 0 ? 0 : 1, tj = tile == 2 ? 1 : 0;
            f32x16 acc;
#pragma unroll
            for (int i = 0; i < 16; ++i) acc[i] = 0.f;
#pragma unroll
            for (int kk = 0; kk < 4; ++kk) { const bf16x8 aq = *(LAS const bf16x8*)(L + DA_QH + (32 * ti + r) * 144 + (16 * kk + 8 * hh) * 2), bk = *(LAS const bf16x8*)(L + DA_KH + (32 * tj + r) * 144 + (16 * kk + 8 * hh) * 2);
                acc = __builtin_amdgcn_mfma_f32_32x32x16_bf16(aq, bk, acc, 0, 0, 0); }
            const int s = 32 * tj + r; const float gs = GC[s]; const int pcol = 32 * tj + kinv(r);
#pragma unroll
            for (int i = 0; i < 16; ++i) { const int c = 32 * ti + crow(i, hh); const float v = (s <= c) ? acc[i] * 0.125f * __expf(GC[c] - gs) : 0.f; ai[c * 64 + pcol] = (bf16)f2bf(v); }
        }
#pragma unroll
        for (int i = 0; i < 16; ++i) ai[crow(i, hh) * 64 + 32 + r] = (bf16)0;
    }
    BAR_SYNC();
    if (wl < 3) { const int ti = wl == 0 ? 0 : 1, tj = wl == 2 ? 1 : 0; LAS float* MM = (LAS float*)(L + DA_MM);
#pragma unroll
        for (int i = 0; i < 16; ++i) MM[(32 * ti + crow(i, hh)) * 68 + 32 * tj + r] = mreg[i]; }
    BAR_SYNC();
    const int role = wl ^ (hw << 1);
    if (role < 2) {
        const LAS float* MM = (const LAS float*)(L + DA_MM); const LAS float* src = (const LAS float*)(L + (role == 0 ? DA_VF : DA_KF));
        float x[64];
#pragma unroll
        for (int c = 0; c < 64; ++c) { const float sc = role == 0 ? BT[c] : BT[c] * __expf(GC[c]); x[c] = sc * src[c * 65 + lane]; }
#pragma unroll
        for (int c = 1; c < 64; ++c) { float a0 = 0.f, a1 = 0.f, a2 = 0.f, a3 = 0.f;
#pragma unroll
            for (int s4 = 0; s4 < (c + 3) / 4; ++s4) { const f32x4 m = *(const LAS f32x4*)(MM + c * 68 + 4 * s4);
                a0 += m[0] * x[4 * s4]; if (4 * s4 + 1 < c) a1 += m[1] * x[4 * s4 + 1]; if (4 * s4 + 2 < c) a2 += m[2] * x[4 * s4 + 2]; if (4 * s4 + 3 < c) a3 += m[3] * x[4 * s4 + 3]; }
            x[c] -= (a0 + a1) + (a2 + a3); }
        if (role == 0) { float* U = (float*)(rec + REC_U) + (size_t)((lane >> 4) * 4) * 64 * 4 + (lane & 15) * 4;
#pragma unroll
            for (int ct = 0; ct < 4; ++ct)
#pragma unroll
                for (int q4 = 0; q4 < 4; ++q4) *(f32x4*)(U + (size_t)(ct * 64 + q4 * 16) * 4) = (f32x4){x[16 * ct + 4 * q4], x[16 * ct + 4 * q4 + 1], x[16 * ct + 4 * q4 + 2], x[16 * ct + 4 * q4 + 3]};
        } else { bf16* wm = (bf16*)(rec + REC_WM) + 32 * (lane >> 5) + kinv(lane & 31);
#pragma unroll
            for (int c = 0; c < 64; ++c) wm[c * 64] = (bf16)f2bf(-x[c]); }
    } else {
        const int t2 = (role - 2) * 64 + lane, d = t2 >> 1, ks = t2 & 1; const LAS float* KF = (const LAS float*)(L + DA_KF); const float gl = GC[63];
        unsigned w[16];
#pragma unroll
        for (int p = 0; p < 32; p += 2) { const int c0 = 32 * ks + kfwd(p), c1 = 32 * ks + kfwd(p + 1); w[p >> 1] = pk2(KF[c0 * 65 + d] * __expf(gl - GC[c0]), KF[c1 * 65 + d] * __expf(gl - GC[c1])); }
        v4u* dst = (v4u*)(rec + REC_KDT + (d * 64 + 32 * ks) * 2);
#pragma unroll
        for (int i = 0; i < 4; ++i) dst[i] = (v4u){w[4 * i], w[4 * i + 1], w[4 * i + 2], w[4 * i + 3]};
    }
    BAR_SYNC();
}

constexpr int DB_SLOT = 53248, DB_WM = 0, DB_QG = 9216, DB_AI = 18432, DB_KDT = 27648, DB_U = 36864, DB_OT = 2 * DB_SLOT;
struct DnRegs { v4u d[12]; };
__device__ __forceinline__ void dnb_load(DnRegs& R, const unsigned char* rec, int lt) {
#pragma unroll
    for (int i = 0; i < 12; ++i) R.d[i] = *(const v4u*)(rec + (size_t)(lt + 256 * i) * 16);
}
__device__ __forceinline__ void dnb_write(const DnRegs& R, LAS unsigned char* slot, int lt) {
#pragma unroll
    for (int i = 0; i < 8; ++i) { const int cm = (lt + 256 * i) & 511; *(LAS v4u*)(slot + (i >> 1) * 9216 + (cm >> 3) * 144 + (cm & 7) * 16) = R.d[i]; }
#pragma unroll
    for (int i = 8; i < 12; ++i) *(LAS v4u*)(slot + DB_U + (lt + 256 * (i - 8)) * 16) = R.d[i];
}
__device__ __forceinline__ void dn_b_scan(const Frame& F, int bh) {
    const Args& A = *F.a; unsigned char* ws = A.ws; const int lane = F.lane, wave = F.wave;
    const int b = bh / NH, h = bh % NH, row0 = b * T;
    const unsigned char* recs = ws + WS_REC + (size_t)bh * NCH * REC_BYTES; const float* EGA = (const float*)(ws + WS_EG) + bh * NCH;
    LAS unsigned char* L = F.lds; LAS float* OT = (LAS float*)(L + DB_OT);
    if (wave < 4) {
        const int col = lane & 15, q4 = lane >> 4, e0 = 16 * wave;
        f32x4 S[4];
#pragma unroll
        for (int i = 0; i < 4; ++i) S[i] = (f32x4){0.f, 0.f, 0.f, 0.f};
        const int aoff = col * 144 + q4 * 16;
        const float eg_lo = EGA[lane], eg_hi = EGA[64 + lane];
        for (int s = 0; s < NCH; ++s) {
            BAR_SYNC();
            LAS const unsigned char* sl = L + (s & 1) * DB_SLOT;
            const float eg = rdlane(s < 64 ? eg_lo : eg_hi, s & 63);
            bf16x8 bS[2];
#pragma unroll
            for (int ks = 0; ks < 2; ++ks) { v4u w; w.x = cvtpk(S[2 * ks][0], S[2 * ks][1]); w.y = cvtpk(S[2 * ks][2], S[2 * ks][3]); w.z = cvtpk(S[2 * ks + 1][0], S[2 * ks + 1][1]); w.w = cvtpk(S[2 * ks + 1][2], S[2 * ks + 1][3]);
                bS[ks] = __builtin_bit_cast(bf16x8, w); }
            f32x4 V[4], O[4];
#pragma unroll
            for (int ct = 0; ct < 4; ++ct) { V[ct] = *(LAS const f32x4*)(sl + DB_U + ((wave * 4 + ct) * 64 + lane) * 16); O[ct] = (f32x4){0.f, 0.f, 0.f, 0.f};
#pragma unroll
                for (int ks = 0; ks < 2; ++ks) { const bf16x8 aw = *(LAS const bf16x8*)(sl + DB_WM + aoff + ct * 2304 + ks * 64), aq = *(LAS const bf16x8*)(sl + DB_QG + aoff + ct * 2304 + ks * 64);
                    V[ct] = __builtin_amdgcn_mfma_f32_16x16x32_bf16(aw, bS[ks], V[ct], 0, 0, 0); O[ct] = __builtin_amdgcn_mfma_f32_16x16x32_bf16(aq, bS[ks], O[ct], 0, 0, 0); } }
            bf16x8 bV[2];
#pragma unroll
            for (int ks = 0; ks < 2; ++ks) { v4u w; w.x = cvtpk(V[2 * ks][0], V[2 * ks][1]); w.y = cvtpk(V[2 * ks][2], V[2 * ks][3]); w.z = cvtpk(V[2 * ks + 1][0], V[2 * ks + 1][1]); w.w = cvtpk(V[2 * ks + 1][2], V[2 * ks + 1][3]);
                bV[ks] = __builtin_bit_cast(bf16x8, w); }
#pragma unroll
            for (int dt = 0; dt < 4; ++dt) { S[dt] = S[dt] * eg;
#pragma unroll
                for (int ks = 0; ks < 2; ++ks) { const bf16x8 ak = *(LAS const bf16x8*)(sl + DB_KDT + aoff + dt * 2304 + ks * 64); S[dt] = __builtin_amdgcn_mfma_f32_16x16x32_bf16(ak, bV[ks], S[dt], 0, 0, 0); } }
#pragma unroll
            for (int ct = 0; ct < 4; ++ct)
#pragma unroll
                for (int ks = 0; ks < 2; ++ks) { const bf16x8 aa = *(LAS const bf16x8*)(sl + DB_AI + aoff + ct * 2304 + ks * 64); O[ct] = __builtin_amdgcn_mfma_f32_16x16x32_bf16(aa, bV[ks], O[ct], 0, 0, 0); }
            BAR_SYNC();
#pragma unroll
            for (int ct = 0; ct < 4; ++ct)
#pragma unroll
                for (int i = 0; i < 4; ++i) OT[(16 * ct + 4 * q4 + i) * 68 + e0 + col] = O[ct][i];
        }
        BAR_SYNC();
        float* So = A.out + O_SP + (size_t)bh * 4096;
#pragma unroll
        for (int dt = 0; dt < 4; ++dt)
#pragma unroll
            for (int i = 0; i < 4; ++i) So[(16 * dt + 4 * q4 + i) * 64 + e0 + col] = S[dt][i];
    } else {
        const int lt = F.tid - 256, rr = lt >> 2, qq = lt & 3;
        const bf16* GATE = (const bf16*)(ws + WS_GATE); bf16* MIX = (bf16*)(ws + WS_MIX);
        float gain[16];
        { const f32x4* gp = (const f32x4*)((const float*)A.in[I_ONORM] + 16 * qq);
#pragma unroll
          for (int i = 0; i < 4; ++i) { const f32x4 g4 = gp[i]; gain[4 * i] = g4[0]; gain[4 * i + 1] = g4[1]; gain[4 * i + 2] = g4[2]; gain[4 * i + 3] = g4[3]; } }
        DnRegs RA, RB; v4u G0a, G0b, G1a, G1b;
        dnb_load(RA, recs, lt); dnb_load(RB, recs + REC_BYTES, lt);
        dnb_write(RA, L, lt);
        dnb_load(RA, recs + (size_t)2 * REC_BYTES, lt);
        G0a = G0b = G1a = G1b = (v4u){0u, 0u, 0u, 0u};
#define DNB_EPI(sp, Ga, Gb) do {   \
            float ss = 0.f; _Pragma("unroll") for (int i = 0; i < 16; ++i) ss += rd[i] * rd[i]; ss += __shfl_xor(ss, 1); ss += __shfl_xor(ss, 2); \
            const float rs = rsqrtf(ss * (1.f / 64.f) + EPS); const unsigned gw_[8] = {Ga.x, Ga.y, Ga.z, Ga.w, Gb.x, Gb.y, Gb.z, Gb.w}; unsigned ow[8]; \
            _Pragma("unroll") for (int i = 0; i < 8; ++i) ow[i] = pk2(rd[2 * i] * rs * gain[2 * i] * bf2f(gw_[i] & 0xffff), rd[2 * i + 1] * rs * gain[2 * i + 1] * bf2f(gw_[i] >> 16)); \
            v4u* mp = (v4u*)(MIX + (size_t)(row0 + (sp) * 64 + rr) * D + h * 64 + 16 * qq); mp[0] = (v4u){ow[0], ow[1], ow[2], ow[3]}; mp[1] = (v4u){ow[4], ow[5], ow[6], ow[7]}; } while (0)
#define DNB_ITER(s, RW, Gca, Gcb, Gpa, Gpb) do {   \
            BAR_SYNC(); \
            float rd[16]; if ((s) > 0) { _Pragma("unroll") for (int i = 0; i < 4; ++i) { const f32x4 t4_ = *(LAS const f32x4*)(OT + rr * 68 + 16 * qq + 4 * i); rd[4 * i] = t4_[0]; rd[4 * i + 1] = t4_[1]; rd[4 * i + 2] = t4_[2]; rd[4 * i + 3] = t4_[3]; } } \
            BAR_SYNC(); \
            if ((s) > 0) DNB_EPI((s) - 1, Gpa, Gpb); \
            { const v4u* gp_ = (const v4u*)(GATE + (size_t)(row0 + (s) * 64 + rr) * MIXW + h * 64 + 16 * qq); Gca = gp_[0]; Gcb = gp_[1]; } \
            if ((s) + 1 < NCH) dnb_write(RW, L + (((s) + 1) & 1) * DB_SLOT, lt); \
            if ((s) + 3 < NCH) dnb_load(RW, recs + (size_t)((s) + 3) * REC_BYTES, lt); } while (0)
        for (int s = 0; s < NCH; s += 2) { DNB_ITER(s, RB, G0a, G0b, G1a, G1b); DNB_ITER(s + 1, RA, G1a, G1b, G0a, G0b); }
        BAR_SYNC();
        { float rd[16];
#pragma unroll
          for (int i = 0; i < 4; ++i) { const f32x4 t4_ = *(LAS const f32x4*)(OT + rr * 68 + 16 * qq + 4 * i); rd[4 * i] = t4_[0]; rd[4 * i + 1] = t4_[1]; rd[4 * i + 2] = t4_[2]; rd[4 * i + 3] = t4_[3]; }
          DNB_EPI(NCH - 1, G1a, G1b); }
#undef DNB_ITER
#undef DNB_EPI
    }
}

enum Phase { PH_PRO = 0, PH_UP0A, PH_DN0A, PH_INA, PH_DNA, PH_SCAN, PH_OUT0, PH_UP0B, PH_DN0B, PH_UP1A, PH_DN1A, PH_INB, PH_GATE, PH_ATT, PH_COMB, PH_OUT1, PH_UP1B, PH_DN1B, PH_FIN, N_PHASES };
__global__ void __launch_bounds__(NWAVES * 64, 2) mk_fwd(Args args) {
    extern __shared__ __attribute__((aligned(16))) unsigned char lds[];
    Frame F;
    F.lds = (LAS unsigned char*)lds; F.tid = threadIdx.x; F.lane = F.tid & 63; F.wave = __builtin_amdgcn_readfirstlane(F.tid >> 6); F.G = gridDim.x; F.a = &args;
    unsigned char* ws = args.ws;
    volatile LAS unsigned* MISC = (volatile LAS unsigned*)(F.lds + MISC_OFF);
    for (int u = F.tid; u < (LDS_BYTES - LDSCTL_OFF) / 4; u += NWAVES * 64) ((LAS unsigned*)(F.lds + LDSCTL_OFF))[u] = 0u;
    __syncthreads();
    XcdBarrier bar; bar.bar = (unsigned*)(ws + WS_CTL) + CW_BAR; bar.x = 0; bar.st = nullptr;
    if (args.mode == 2) bar = xcd_barrier_post((unsigned*)(ws + WS_CTL) + CW_BAR, MISC + 8);
    const int lo = args.ph_lo, hi = args.ph_hi;
#ifndef PH_MASK
#define PH_MASK 0x7ffff
#endif
#define IN(k) ((((PH_MASK) >> (k)) & 1) && lo <= (k) && (k) < hi)
#define SEAM(k) do { if (IN(k) && IN((k) + 1)) { if (args.mode == 1 || (args.mode == 2 && (k) == 0)) cg::this_grid().sync(); else if (args.mode == 2) xcd_barrier(bar); } } while (0)
    LAS unsigned char* ring = F.lds + RING_OFF;
    bf16* XB = (bf16*)(ws + WS_XB); float* X = (float*)(ws + WS_X); bf16* HB = (bf16*)(ws + WS_H); float* SSQ = (float*)(ws + WS_SSQ); bf16* MIX = (bf16*)(ws + WS_MIX);
    const float* ROPE = (const float*)(ws + WS_ROPE);
    const int bx = (int)blockIdx.x, gw = bx * NWAVES + F.wave, NGW = F.G * NWAVES;

    if (IN(PH_PRO)) { p0_prologue(F); } SEAM(PH_PRO);

    if (IN(PH_UP0A)) {
        if (bx >= F.G - 8) { pg8::Gemm g{(const bf16*)(ws + WS_MEMB), (const bf16*)(ws + WS_WMEM), 512, D, D}; pg8::StaticOrder S; S.init(512, D, 8, bx - (F.G - 8));
            pg8::EpiMem E{args.out + O_MKP, (long)(O_MVP - O_MKP), (const float*)(ws + WS_SSQM)};
            pg8::gemm_phase<pg8::EpiMem, pg8::StaticOrder, true, true>(ring, g, S, E); }
        pg8::Gemm g{XB, (const bf16*)(ws + WS_W13), MT, NUP, D}; pg8::StaticOrder S; S.init(MT, NUP, F.G, bx);
        pg8::EpiUp E{HB, SSQ + (size_t)0 * MT * 16, NUP / 256, nullptr, 0, nullptr, 0, ROPE};
        pg8::gemm_phase<pg8::EpiUp, pg8::StaticOrder, true, true>(ring, g, S, E);
    } SEAM(PH_UP0A);
    if (IN(PH_DN0A)) {
        pg8::Gemm g{HB, (const bf16*)(ws + WS_W2T), MT, D, FF}; pg8::StaticOrder S; S.init(MT, D, F.G, bx);
        pg8::EpiResid E{X, XB, SSQ + (size_t)1 * MT * 16, 0.5f};
        pg8::gemm_phase<pg8::EpiResid, pg8::StaticOrder, true, true>(ring, g, S, E);
    } SEAM(PH_DN0A);
    if (IN(PH_INA)) {
        pg8::Gemm g{XB, (const bf16*)(ws + WS_WINA), MT, INA_P, D}; pg8::StaticOrder S; S.init(MT, INA_P, F.G, bx);
        pg8::EpiInA E{(bf16*)(ws + WS_QKV), (bf16*)(ws + WS_GATE), (bf16*)(ws + WS_QMEM), (float*)(ws + WS_GB), SSQ + (size_t)1 * MT * 16, args.out + O_CONVP, args.out + O_CONVS,
                      (const float*)args.in[I_ALOG], (const float*)args.in[I_DTB]};
        pg8::gemm_phase<pg8::EpiInA, pg8::StaticOrder, true, true>(ring, g, S, E);
    } SEAM(PH_INA);
    if (IN(PH_DNA)) { for (int pair = bx; pair < NCHUNKS / 2; pair += F.G) dn_a_pair(F, pair); } SEAM(PH_DNA);
    if (IN(PH_SCAN)) {
        constexpr int NSCAN = NB * NH;
        if (bx < NSCAN) dn_b_scan(F, bx);
        else {
            const int w = (bx - NSCAN) * NWAVES + F.wave, NW = (F.G - NSCAN) * NWAVES;
            for (int k = w; k < SB * NBLK; k += NW) kbar_s_task(F, k / NBLK, k % NBLK);
            for (int it = w; it < SB * NH; it += NW) { const int b = it / NH, h = it % NH;
                dn_scan_seq(F, MP + b * ST, ST, h, (const float*)args.in[I_SCONV] + (size_t)b * 3 * QKVW, (const float*)args.in[I_SS] + (size_t)it * 4096, args.out + O_SS + (size_t)it * 4096); }
            for (int k = w; k < MS * 4; k += NW) mem_task(F, MP + (k >> 2), k & 3, 0);
            attn_units(F, false, 0, bx - NSCAN, F.G - NSCAN);
        }
    } SEAM(PH_SCAN);
    if (IN(PH_OUT0)) {
        pg8::Gemm g{MIX, (const bf16*)(ws + WS_WOUT), MT, D, D}; pg8::StaticOrder S; S.init(MT, D, F.G, bx);
        pg8::EpiResid E{X, XB, SSQ + (size_t)2 * MT * 16, 1.0f};
        pg8::gemm_phase<pg8::EpiResid, pg8::StaticOrder, true, true>(ring, g, S, E);
    } SEAM(PH_OUT0);
    if (IN(PH_UP0B)) {
        pg8::Gemm g{XB, (const bf16*)(ws + WS_W13 + 1 * SZ_W13), MT, NUP, D}; pg8::StaticOrder S; S.init(MT, NUP, F.G, bx);
        pg8::EpiUp E{HB, SSQ + (size_t)2 * MT * 16, NUP / 256, nullptr, 0, nullptr, 0, ROPE};
        pg8::gemm_phase<pg8::EpiUp, pg8::StaticOrder, true, true>(ring, g, S, E);
    } SEAM(PH_UP0B);
    if (IN(PH_DN0B)) {
        pg8::Gemm g{HB, (const bf16*)(ws + WS_W2T + 1 * SZ_W2T), MT, D, FF}; pg8::StaticOrder S; S.init(MT, D, F.G, bx);
        pg8::EpiResid E{X, XB, SSQ + (size_t)3 * MT * 16, 0.5f};
        pg8::gemm_phase<pg8::EpiResid, pg8::StaticOrder, true, true>(ring, g, S, E);
    } SEAM(PH_DN0B);
    if (IN(PH_UP1A)) {
        pg8::Gemm g{XB, (const bf16*)(ws + WS_W13 + 2 * SZ_W13), MT, NUPKV, D}; pg8::StaticOrder S; S.init(MT, NUPKV, F.G, bx);
        pg8::EpiUp E{HB, SSQ + (size_t)3 * MT * 16, NUP / 256, args.out + O_KP, (long)(O_VP - O_KP), args.out + O_KS, (long)(O_VS - O_KS), ROPE};
        pg8::gemm_phase<pg8::EpiUp, pg8::StaticOrder, true, true>(ring, g, S, E);
    } SEAM(PH_UP1A);
    if (IN(PH_DN1A)) {
        for (int it = gw; it < NB * NBLK * NKV; it += NGW) kbar_task(F, true, it / (NBLK * NKV), (it / NKV) % NBLK, it % NKV);
        pg8::Gemm g{HB, (const bf16*)(ws + WS_W2T + 2 * SZ_W2T), MT, D, FF}; pg8::StaticOrder S; S.init(MT, D, F.G, bx);
        pg8::EpiResid E{X, XB, SSQ + (size_t)4 * MT * 16, 0.5f};
        pg8::gemm_phase<pg8::EpiResid, pg8::StaticOrder, true, true>(ring, g, S, E);
    } SEAM(PH_DN1A);
    if (IN(PH_INB)) {
        pg8::Gemm g{XB, (const bf16*)(ws + WS_WINB), MT, D, D}; pg8::StaticOrder S; S.init(MT, D, F.G, bx);
        pg8::EpiInB E{(bf16*)(ws + WS_QB), (bf16*)(ws + WS_QMEM), SSQ + (size_t)4 * MT * 16, ROPE};
        pg8::gemm_phase<pg8::EpiInB, pg8::StaticOrder, true, true>(ring, g, S, E);
    } SEAM(PH_INB);
    if (IN(PH_GATE)) {
        for (int it = gw; it < NB * NH * (T / 64); it += NGW) { const int b = it / (NH * (T / 64)), rem = it % (NH * (T / 64)); gate_task(F, b, rem % NH, (rem / NH) * 64); }
        for (int it = gw; it < MS * 16; it += NGW) { const int row = MP + (it >> 4), hh = it & 15; if (hh < NH) moba_task(F, row, hh); else mem_task(F, row, hh - NH, 1); }
    } SEAM(PH_GATE);
    if (IN(PH_ATT)) { attn_units(F, true, 1, bx, F.G); } SEAM(PH_ATT);
    if (IN(PH_COMB)) { combine_partials(F); } SEAM(PH_COMB);
    if (IN(PH_OUT1)) {
        pg8::Gemm g{MIX, (const bf16*)(ws + WS_WOUT) + (size_t)D * D, MT, D, D}; pg8::StaticOrder S; S.init(MT, D, F.G, bx);
        pg8::EpiResid E{X, XB, SSQ + (size_t)5 * MT * 16, 1.0f};
        pg8::gemm_phase<pg8::EpiResid, pg8::StaticOrder, true, true>(ring, g, S, E);
    } SEAM(PH_OUT1);
    if (IN(PH_UP1B)) {
        pg8::Gemm g{XB, (const bf16*)(ws + WS_W13 + 3 * SZ_W13), MT, NUP, D}; pg8::StaticOrder S; S.init(MT, NUP, F.G, bx);
        pg8::EpiUp E{HB, SSQ + (size_t)5 * MT * 16, NUP / 256, nullptr, 0, nullptr, 0, ROPE};
        pg8::gemm_phase<pg8::EpiUp, pg8::StaticOrder, true, true>(ring, g, S, E);
    } SEAM(PH_UP1B);
    if (IN(PH_DN1B)) {
        pg8::Gemm g{HB, (const bf16*)(ws + WS_W2T + 3 * SZ_W2T), MT, D, FF}; pg8::StaticOrder S; S.init(MT, D, F.G, bx);
        pg8::EpiResid E{X, XB, SSQ + (size_t)6 * MT * 16, 0.5f};
        pg8::gemm_phase<pg8::EpiResid, pg8::StaticOrder, true, true>(ring, g, S, E);
    } SEAM(PH_DN1B);
    if (IN(PH_FIN)) {
        const float* fg = (const float*)args.in[I_FINN]; const float* sq = SSQ + (size_t)6 * MT * 16;
        for (int m = gw; m < MV; m += NGW) { const float rs = pg8::rstd_row(sq, m); float* dst = m < MP ? args.out + O_YP + (size_t)m * D : args.out + O_YS + (size_t)(m - MP) * D;
#pragma unroll
            for (int j = 0; j < 4; ++j) { const f32x4 v = *((const f32x4*)(X + (size_t)m * D) + 64 * j + F.lane); const f32x4 gv = *((const f32x4*)fg + 64 * j + F.lane);
                *((f32x4*)dst + 64 * j + F.lane) = v * rs * gv; } }
    }
#undef IN
#undef SEAM
}

#ifndef MK_MODE
#define MK_MODE 1
#endif
extern "C" void kernel_launch(void* const* d_in, const int* in_sizes, int n_in, void* d_out, int out_size, void* d_ws, size_t ws_size, hipStream_t stream) {
    static int grid = 0;
    if (grid == 0) {
        if (n_in != N_IN || (size_t)out_size != O_END || ws_size < WS_END) { fprintf(stderr, "kernel_launch: shape mismatch: n_in %d (want %d), out %d (want %zu), ws %zu (want >= %zu); nothing launched\n", n_in, (int)N_IN, out_size, (size_t)O_END, ws_size, (size_t)WS_END); grid = -1; return; }
        int dev = 0, cus = 0, per_cu = 0;
        if (hipGetDevice(&dev) != hipSuccess || hipDeviceGetAttribute(&cus, hipDeviceAttributeMultiprocessorCount, dev) != hipSuccess) { fprintf(stderr, "kernel_launch: device query failed\n"); grid = -1; return; }
        if (hipFuncSetAttribute((const void*)mk_fwd, hipFuncAttributeMaxDynamicSharedMemorySize, LDS_BYTES) != hipSuccess) { fprintf(stderr, "kernel_launch: hipFuncSetAttribute failed\n"); grid = -1; return; }
        if (hipOccupancyMaxActiveBlocksPerMultiprocessor(&per_cu, (const void*)mk_fwd, NWAVES * 64, LDS_BYTES) != hipSuccess || per_cu < 1) { fprintf(stderr, "kernel_launch: occupancy query says %d blocks per CU\n", per_cu); per_cu = 1; }
        (void)hipGetLastError();
        grid = cus;
        if (grid > 256) grid = 256;
        fprintf(stderr, "kernel_launch: grid %d (cus %d, occupancy %d per CU), mode %d\n", grid, cus, per_cu, (int)MK_MODE);
    }
    if (grid < 0) return;
    Args a{};
    for (int i = 0; i < N_IN; ++i) a.in[i] = d_in[i];
    a.out = (float*)d_out; a.ws = (unsigned char*)d_ws; a.mode = MK_MODE;
    if (MK_MODE == 0) {
        for (int p = 0; p < N_PHASES; ++p) { a.ph_lo = p; a.ph_hi = p + 1; hipLaunchKernelGGL(mk_fwd, dim3(grid), dim3(NWAVES * 64), LDS_BYTES, stream, a); }
    } else {
        if (MK_MODE == 2) (void)hipMemsetAsync((char*)d_ws + WS_CTL, 0, CTL_ZERO_BYTES, stream);
        a.ph_lo = 0; a.ph_hi = N_PHASES;
        void* kargs[] = {&a};
        hipError_t e = hipLaunchCooperativeKernel((const void*)mk_fwd, dim3(grid), dim3(NWAVES * 64), kargs, LDS_BYTES, stream);
        if (e != hipSuccess) fprintf(stderr, "kernel_launch: cooperative launch failed: %s (grid %d)\n", hipGetErrorString(e), grid);
    }
}
```
